# Optimizing an MI355X kernel written in HIP

```python
import jax, jax.numpy as jnp
from jax import lax
import numpy as np

D_MODEL = 1024
BATCH = 2
SEQ = 8192
DEPTH = 1
DEC_BATCH = 128
DEC_SEQ = 1
PAST_LEN = 8192
PAGE_SIZE = 128

RW_HEADS = 8
RW_HEAD_DIM = 64
RW_WIDTH = RW_HEADS * RW_HEAD_DIM
DECAY_LORA = 64
AAA_LORA = 64
GATE_LORA = 128
RW_COLS = 3 * RW_WIDTH + DECAY_LORA + AAA_LORA + GATE_LORA
RW_SPLITS = (RW_WIDTH, 2 * RW_WIDTH, 3 * RW_WIDTH, 3 * RW_WIDTH + DECAY_LORA,
             3 * RW_WIDTH + DECAY_LORA + AAA_LORA)
GN_EPS = 64e-5
SWA_HEADS = 8
SWA_KV_HEADS = 2
SWA_GROUPS = SWA_HEADS // SWA_KV_HEADS
SWA_HEAD_DIM = 64
SWA_Q = SWA_HEADS * SWA_HEAD_DIM
SWA_KV = SWA_KV_HEADS * SWA_HEAD_DIM
WINDOW = 128
BLOCK = 128
ROPE_THETA = 500000.0
ROPE_DIM = SWA_HEAD_DIM // 4
MEM_LEN = 256
MEM_HEADS = 4
MEM_HEAD_DIM = 128
MEM_WIDTH = MEM_HEADS * MEM_HEAD_DIM
N_BRANCH = 3
D_FF = 4 * D_MODEL
NORM_EPS = 1e-5
IN_COLS = RW_COLS + SWA_Q + 2 * SWA_KV + MEM_WIDTH + N_BRANCH * D_MODEL
IN_SPLITS = (RW_COLS, RW_COLS + SWA_Q, RW_COLS + SWA_Q + SWA_KV, RW_COLS + SWA_Q + 2 * SWA_KV,
             RW_COLS + SWA_Q + 2 * SWA_KV + MEM_WIDTH)

kernel_name = 'hybrid_rwkv7_swa_sink_memxattn_decode_step'

F32 = jnp.float32


def _rmsnorm(x, g):
    xf = x.astype(F32)
    y = xf * lax.rsqrt(jnp.mean(xf * xf, axis=-1, keepdims=True) + NORM_EPS)
    return (y * g.astype(F32)).astype(x.dtype)


def _rope(x, pos):
    half = ROPE_DIM // 2
    inv_freq = jnp.power(jnp.float32(ROPE_THETA), -jnp.arange(half, dtype=F32) * (2.0 / ROPE_DIM))
    ang = pos.astype(F32)[:, None] * inv_freq[None, :]
    cos = jnp.cos(ang)[:, None, :]
    sin = jnp.sin(ang)[:, None, :]
    xf = x.astype(F32)
    x1 = xf[..., :half]
    x2 = xf[..., half:ROPE_DIM]
    out = jnp.concatenate([x1 * cos - x2 * sin, x2 * cos + x1 * sin, xf[..., ROPE_DIM:]], axis=-1)
    return out.astype(x.dtype)


def _rwkv_scan(S0, r, decay, k, v, kk, a):
    def step(S, inp):
        r_t, w_t, k_t, v_t, kk_t, a_t = inp
        sa = jnp.einsum('bhvk,bhk->bhv', S, -kk_t)
        S = (S * w_t[:, :, None, :] + sa[..., None] * (kk_t * a_t)[:, :, None, :]
             + v_t[..., None] * k_t[:, :, None, :])
        y = jnp.einsum('bhvk,bhk->bhv', S, r_t)
        return S, y
    xs = tuple(jnp.moveaxis(t, 1, 0) for t in (r, decay, k, v, kk, a))
    S, ys = lax.scan(step, S0.astype(F32), xs)
    return S, jnp.moveaxis(ys, 0, 1)


def _rwkv_branch(z, z_prev, S0, p):
    B, T, _ = z.shape
    zs = z + (z_prev - z) * p['rw_mu']
    r, k, v, wd, ad, gd = jnp.split(zs, RW_SPLITS, axis=-1)
    w_log = -jax.nn.softplus(-(p['rw_w0'] + jnp.tanh(wd) @ p['rw_w2'])) - 0.5
    decay = jnp.exp(-jnp.exp(w_log.astype(F32)))
    a = jax.nn.sigmoid(p['rw_a0'] + ad @ p['rw_a2'])
    g = jax.nn.sigmoid(gd) @ p['rw_g2']

    def heads(t):
        return t.astype(F32).reshape(B, T, RW_HEADS, RW_HEAD_DIM)

    kk = heads(k * p['rw_k_k'])
    kk = kk / jnp.maximum(jnp.sqrt(jnp.sum(kk * kk, axis=-1, keepdims=True)), 1e-12)
    kh = heads(k * (1.0 + (a - 1.0) * p['rw_k_a']))
    rh, vh, ah, dh = heads(r), heads(v), heads(a), heads(decay)
    S_new, y = _rwkv_scan(S0, rh, dh, kh, vh, kk, ah)
    mu = jnp.mean(y, axis=-1, keepdims=True)
    var = jnp.mean(jnp.square(y - mu), axis=-1, keepdims=True)
    y = ((y - mu) * lax.rsqrt(var + GN_EPS)).reshape(B, T, RW_WIDTH)
    y = y * p['rw_ln_w'].astype(F32) + p['rw_ln_b'].astype(F32)
    bonus = jnp.sum(rh * kh * p['rw_r_k'].astype(F32), axis=-1, keepdims=True) * vh
    out = (y + bonus.reshape(B, T, RW_WIDTH)) * g.astype(F32)
    return out.astype(z.dtype), S_new


def _sink_attn(q, k, v, q_pos, k_pos, sinks):
    s = jnp.einsum('...qhgd,...shd->...hgqs', q.astype(F32), k.astype(F32)) * (SWA_HEAD_DIM ** -0.5)
    rel = q_pos[..., :, None] - k_pos[..., None, :]
    valid = (rel >= 0) & (rel <= WINDOW) & (k_pos[..., None, :] >= 0)
    s = jnp.where(valid[..., None, None, :, :], s, -jnp.inf)
    sink = jnp.broadcast_to(sinks.astype(F32).reshape(SWA_KV_HEADS, SWA_GROUPS, 1, 1), s.shape[:-1] + (1,))
    pr = jax.nn.softmax(jnp.concatenate([s, sink], axis=-1), axis=-1)[..., :-1]
    o = jnp.einsum('...hgqs,...shd->...qhgd', pr, v.astype(F32))
    return o.astype(v.dtype)


def _swa_prompt(q, k, v, sinks):
    B, T = q.shape[0], q.shape[1]
    nb = T // BLOCK
    qb = q.reshape(B, nb, BLOCK, SWA_KV_HEADS, SWA_GROUPS, SWA_HEAD_DIM)
    kb = k.reshape(B, nb, BLOCK, SWA_KV_HEADS, SWA_HEAD_DIM)
    vb = v.reshape(B, nb, BLOCK, SWA_KV_HEADS, SWA_HEAD_DIM)
    pad = ((0, 0), (1, 0), (0, 0), (0, 0), (0, 0))
    k_band = jnp.concatenate([jnp.pad(kb, pad)[:, :-1], kb], axis=2)
    v_band = jnp.concatenate([jnp.pad(vb, pad)[:, :-1], vb], axis=2)
    pos = jnp.arange(T, dtype=jnp.int32).reshape(nb, BLOCK)
    k_pos = jnp.concatenate([pos - BLOCK, pos], axis=1)
    o = _sink_attn(qb, k_band, v_band, pos, k_pos, sinks).reshape(B, T, SWA_Q)
    keep = min(WINDOW, T)
    return o, k[:, T - keep:], v[:, T - keep:]


def _swa_sample(q, k, v, k_past, v_past, sinks):
    B, T = q.shape[0], q.shape[1]
    W = k_past.shape[1]
    q_pos = PAST_LEN + jnp.arange(T, dtype=jnp.int32)
    k_pos = jnp.concatenate([PAST_LEN - W + jnp.arange(W, dtype=jnp.int32), q_pos])
    k_all = jnp.concatenate([k_past.astype(k.dtype), k], axis=1)
    v_all = jnp.concatenate([v_past.astype(v.dtype), v], axis=1)
    o = _sink_attn(q, k_all, v_all, q_pos, k_pos, sinks).reshape(B, T, SWA_Q)
    return o, k_all[:, -W:], v_all[:, -W:]


def _mem_kv(mem, mem_norm, w_mem_kv, xk_norm):
    B, M, _ = mem.shape
    kv = _rmsnorm(mem, mem_norm) @ w_mem_kv
    mk = kv[..., :MEM_WIDTH].reshape(B, M, MEM_HEADS, MEM_HEAD_DIM)
    mv = kv[..., MEM_WIDTH:].reshape(B, M, MEM_HEADS, MEM_HEAD_DIM)
    return _rmsnorm(mk, xk_norm), mv


def _mem_attn(q, mk, mv):
    s = jnp.einsum('bthd,bmhd->bhtm', q.astype(F32), mk.astype(F32)) * (MEM_HEAD_DIM ** -0.5)
    pr = jax.nn.softmax(s, axis=-1)
    o = jnp.einsum('bhtm,bmhd->bthd', pr, mv.astype(F32))
    return o.astype(q.dtype)


def _layer(x, pos, z_prev0, S0, k_past, v_past, mem_k, mem_v, p):
    B, T, _ = x.shape
    h = _rmsnorm(x, p['norm_mix'])
    proj = h @ p['w_in']
    z, q, k, v, xq, gates = jnp.split(proj, IN_SPLITS, axis=-1)
    z_prev = jnp.concatenate([z_prev0[:, None, :].astype(z.dtype), z[:, :-1]], axis=1)
    out_a, S_new = _rwkv_branch(z, z_prev, S0, p)
    qh = _rope(_rmsnorm(q.reshape(B, T, SWA_HEADS, SWA_HEAD_DIM), p['q_norm']), pos)
    kh = _rope(_rmsnorm(k.reshape(B, T, SWA_KV_HEADS, SWA_HEAD_DIM), p['k_norm']), pos)
    vh = v.reshape(B, T, SWA_KV_HEADS, SWA_HEAD_DIM)
    qh = qh.reshape(B, T, SWA_KV_HEADS, SWA_GROUPS, SWA_HEAD_DIM)
    if k_past is None:
        out_b, k_keep, v_keep = _swa_prompt(qh, kh, vh, p['swa_sinks'])
    else:
        out_b, k_keep, v_keep = _swa_sample(qh, kh, vh, k_past, v_past, p['swa_sinks'])
    xqh = _rmsnorm(xq.reshape(B, T, MEM_HEADS, MEM_HEAD_DIM), p['xq_norm'])
    out_c = _mem_attn(xqh, mem_k, mem_v).reshape(B, T, MEM_WIDTH)
    g = jax.nn.sigmoid(gates)
    merged = (g[..., :D_MODEL] * (out_a @ p['w_br_a'])
              + g[..., D_MODEL:2 * D_MODEL] * (out_b @ p['w_br_b'])
              + g[..., 2 * D_MODEL:] * (out_c @ p['w_br_c']))
    x = x + merged @ p['w_out']
    h2 = _rmsnorm(x, p['norm_ffn'])
    x = x + jnp.square(jax.nn.relu(h2 @ p['w_up'])) @ p['w_down']
    return x, S_new, z[:, -1], k_keep, v_keep


def setup_inputs(seed: int = 0) -> dict:
    key = jax.random.key(seed)
    ks = jax.random.split(key, 36)

    def nrm(i, shape, scale):
        return jax.random.normal(ks[i], shape, F32) * scale

    def gain(i, n):
        return 1.0 + nrm(i, (DEPTH, n), 0.02)

    w_swa = min(WINDOW, PAST_LEN)
    return {
        'x_prompt': nrm(0, (BATCH, SEQ, D_MODEL), 1.0),
        'x_sample': nrm(1, (DEC_BATCH, DEC_SEQ, D_MODEL), 1.0),
        'state_rwkv': nrm(2, (DEPTH, DEC_BATCH, RW_HEADS, RW_HEAD_DIM, RW_HEAD_DIM), 0.3),
        'state_rwkv_shift': nrm(3, (DEPTH, DEC_BATCH, RW_COLS), 1.0),
        'cache_swa_k': nrm(4, (DEPTH, DEC_BATCH, w_swa, SWA_KV_HEADS, SWA_HEAD_DIM), 1.0),
        'cache_swa_v': nrm(5, (DEPTH, DEC_BATCH, w_swa, SWA_KV_HEADS, SWA_HEAD_DIM), 1.0),
        'cache_mem_k': nrm(6, (DEPTH, DEC_BATCH, MEM_LEN, MEM_HEADS, MEM_HEAD_DIM), 1.0),
        'cache_mem_v': nrm(7, (DEPTH, DEC_BATCH, MEM_LEN, MEM_HEADS, MEM_HEAD_DIM), 1.0),
        'mem_prompt': nrm(8, (BATCH, MEM_LEN, D_MODEL), 1.0),
        'norm_mix': gain(9, D_MODEL),
        'w_in': nrm(10, (DEPTH, D_MODEL, IN_COLS), D_MODEL ** -0.5),
        'rw_mu': jax.random.uniform(ks[11], (DEPTH, RW_COLS), F32),
        'rw_w0': -2.0 + nrm(12, (DEPTH, RW_WIDTH), 0.5),
        'rw_w2': nrm(13, (DEPTH, DECAY_LORA, RW_WIDTH), 0.5 * DECAY_LORA ** -0.5),
        'rw_a0': nrm(14, (DEPTH, RW_WIDTH), 0.1),
        'rw_a2': nrm(15, (DEPTH, AAA_LORA, RW_WIDTH), AAA_LORA ** -0.5),
        'rw_g2': nrm(16, (DEPTH, GATE_LORA, RW_WIDTH), GATE_LORA ** -0.5),
        'rw_k_k': 0.85 + nrm(17, (DEPTH, RW_WIDTH), 0.05),
        'rw_k_a': 1.0 + nrm(18, (DEPTH, RW_WIDTH), 0.05),
        'rw_r_k': nrm(19, (DEPTH, RW_HEADS, RW_HEAD_DIM), 0.1),
        'rw_ln_w': gain(20, RW_WIDTH),
        'rw_ln_b': nrm(21, (DEPTH, RW_WIDTH), 0.01),
        'q_norm': gain(22, SWA_HEAD_DIM),
        'k_norm': gain(23, SWA_HEAD_DIM),
        'swa_sinks': nrm(24, (DEPTH, SWA_HEADS), 1.0),
        'mem_norm': gain(25, D_MODEL),
        'w_mem_kv': nrm(26, (DEPTH, D_MODEL, 2 * MEM_WIDTH), D_MODEL ** -0.5),
        'xq_norm': gain(27, MEM_HEAD_DIM),
        'xk_norm': gain(28, MEM_HEAD_DIM),
        'w_br_a': nrm(29, (DEPTH, RW_WIDTH, D_MODEL), RW_WIDTH ** -0.5),
        'w_br_b': nrm(30, (DEPTH, SWA_Q, D_MODEL), SWA_Q ** -0.5),
        'w_br_c': nrm(31, (DEPTH, MEM_WIDTH, D_MODEL), MEM_WIDTH ** -0.5),
        'w_out': nrm(32, (DEPTH, D_MODEL, D_MODEL), D_MODEL ** -0.5),
        'norm_ffn': gain(33, D_MODEL),
        'w_up': nrm(34, (DEPTH, D_MODEL, D_FF), D_MODEL ** -0.5),
        'w_down': nrm(35, (DEPTH, D_FF, D_MODEL), D_FF ** -0.5),
    }


def reference(x_prompt, x_sample, state_rwkv, state_rwkv_shift, cache_swa_k, cache_swa_v,
              cache_mem_k, cache_mem_v, mem_prompt, norm_mix, w_in, rw_mu, rw_w0, rw_w2,
              rw_a0, rw_a2, rw_g2, rw_k_k, rw_k_a, rw_r_k, rw_ln_w, rw_ln_b, q_norm, k_norm,
              swa_sinks, mem_norm, w_mem_kv, xq_norm, xk_norm, w_br_a, w_br_b, w_br_c, w_out,
              norm_ffn, w_up, w_down):
    B, T, _ = x_prompt.shape
    pos_p = jnp.arange(T, dtype=jnp.int32)
    pos_s = PAST_LEN + jnp.arange(x_sample.shape[1], dtype=jnp.int32)
    yp, ys = x_prompt, x_sample
    lp_S, lp_z, lp_k, lp_v, lp_mk, lp_mv = [], [], [], [], [], []
    ls_S, ls_z, ls_k, ls_v = [], [], [], []
    for l in range(DEPTH):
        p = dict(norm_mix=norm_mix[l], w_in=w_in[l], rw_mu=rw_mu[l], rw_w0=rw_w0[l],
                 rw_w2=rw_w2[l], rw_a0=rw_a0[l], rw_a2=rw_a2[l], rw_g2=rw_g2[l],
                 rw_k_k=rw_k_k[l], rw_k_a=rw_k_a[l], rw_r_k=rw_r_k[l], rw_ln_w=rw_ln_w[l],
                 rw_ln_b=rw_ln_b[l], q_norm=q_norm[l], k_norm=k_norm[l], swa_sinks=swa_sinks[l],
                 xq_norm=xq_norm[l], w_br_a=w_br_a[l], w_br_b=w_br_b[l], w_br_c=w_br_c[l],
                 w_out=w_out[l], norm_ffn=norm_ffn[l], w_up=w_up[l], w_down=w_down[l])
        mk_p, mv_p = _mem_kv(mem_prompt, mem_norm[l], w_mem_kv[l], xk_norm[l])
        z0 = jnp.zeros((B, RW_COLS), x_prompt.dtype)
        S0 = jnp.zeros((B, RW_HEADS, RW_HEAD_DIM, RW_HEAD_DIM), F32)
        yp, Sp, zp, kp, vp = _layer(yp, pos_p, z0, S0, None, None, mk_p, mv_p, p)
        ys, Ss, zs_, ks_, vs_ = _layer(ys, pos_s, state_rwkv_shift[l], state_rwkv[l],
                                       cache_swa_k[l], cache_swa_v[l],
                                       cache_mem_k[l], cache_mem_v[l], p)
        lp_S.append(Sp); lp_z.append(zp); lp_k.append(kp); lp_v.append(vp)
        lp_mk.append(mk_p); lp_mv.append(mv_p)
        ls_S.append(Ss); ls_z.append(zs_); ls_k.append(ks_); ls_v.append(vs_)
    y_prompt, y_sample = yp, ys
    new_state_rwkv_prompt = jnp.stack(lp_S)
    new_shift_prompt = jnp.stack(lp_z)
    new_swa_k_prompt = jnp.stack(lp_k)
    new_swa_v_prompt = jnp.stack(lp_v)
    new_mem_k_prompt = jnp.stack(lp_mk)
    new_mem_v_prompt = jnp.stack(lp_mv)
    new_state_rwkv_sample = jnp.stack(ls_S)
    new_shift_sample = jnp.stack(ls_z)
    new_swa_k_sample = jnp.stack(ls_k)
    new_swa_v_sample = jnp.stack(ls_v)
    return (y_prompt, y_sample, new_state_rwkv_prompt, new_shift_prompt, new_swa_k_prompt,
            new_swa_v_prompt, new_mem_k_prompt, new_mem_v_prompt, new_state_rwkv_sample,
            new_shift_sample, new_swa_k_sample, new_swa_v_sample)
```

```cpp
#include <hip/hip_runtime.h>
#include <hip/hip_cooperative_groups.h>
#include <cstdio>
#include <cstdint>
namespace cg = cooperative_groups;
__device__ __forceinline__ int lane_id_asm() { int l; asm volatile("v_mbcnt_lo_u32_b32 %0, -1, 0\n\tv_mbcnt_hi_u32_b32 %0, -1, %0" : "=v"(l)); return l; }
namespace pg8 {
#define PG8_LAS __attribute__((address_space(3)))
typedef unsigned short bf16_t;
typedef short bf16x8 __attribute__((ext_vector_type(8)));
typedef float f32x4 __attribute__((ext_vector_type(4)));
typedef unsigned u32x4 __attribute__((ext_vector_type(4)));
constexpr int BM = 256, BK = 64, HALF = 128, HTB = HALF * BK * 2  , STAGE_BYTES = 8 * HTB, NXCD = 8, WGM = 8;

__host__ __device__ __forceinline__ int lds_byte(int r, int c) { const int st = (r >> 4) * 2 + (c >> 5), rr = r & 15, cc = c & 31, ob = rr * 64 + cc * 2; return st * 1024 + (ob ^ (((ob >> 9) & 1) << 5)); }
__host__ __device__ __forceinline__ void stage_rc(int b, int& R, int& C) { const int st = b / 1024, sb = b % 1024, swz = sb ^ (((sb >> 9) & 1) << 5); R = (st >> 1) * 16 + swz / 64; C = (st & 1) * 32 + (swz % 64) / 2; }
__host__ __device__ __forceinline__ int perm32(int rho) { const int n = rho >> 4, i = rho & 15; return 8 * (i >> 2) + 4 * n + (i & 3); }

struct Unit { int pm, pn; };
struct Gemm { const bf16_t* A; const bf16_t* Bt; int M, N, K; };

struct StaticOrder {
    int nM, nN, nwg, G, c;
    __host__ __device__ void init(int M, int N, int G_, int c_) { nM = M / BM; nN = N / BM; nwg = nM * nN; G = G_; c = c_; }
    __host__ __device__ bool next(int i, Unit& u) const {
        const long L = (long)i * G + c; if (L >= nwg) return false;
        int wgid = (int)L; { const int q = nwg / NXCD, r = nwg % NXCD, xcd = wgid % NXCD, off = wgid / NXCD; wgid = (xcd < r ? xcd * (q + 1) : r * (q + 1) + (xcd - r) * q) + off; }
        const int nig = WGM * nN, gid = wgid / nig, fm = gid * WGM, gsz = (nM - fm) < WGM ? (nM - fm) : WGM;
        u.pm = fm + ((wgid % nig) % gsz); u.pn = (wgid % nig) / gsz; return true;
    }
    __device__ __forceinline__ void a_ready(const Unit&) const {}
    __device__ __forceinline__ void done(const Unit&) const {}
};

__device__ __forceinline__ unsigned cvt_pk_bf16(float lo, float hi) { unsigned r; asm volatile("v_cvt_pk_bf16_f32 %0, %1, %2" : "=v"(r) : "v"(lo), "v"(hi)); return r; }
typedef float f32x2 __attribute__((ext_vector_type(2)));
template <class Epi, class Sched, bool ALIGN_EPI = false, bool SP2 = false>
__device__ __forceinline__ void gemm_phase(PG8_LAS unsigned char* lds, const Gemm g, const Sched& S, const Epi& E, int wave_id) {
    const int tid_l = wave_id * 64 + lane_id_asm();
    const int tid = tid_l, wid = __builtin_amdgcn_readfirstlane(tid >> 6), lane = tid & 63, wr = wid >> 2, wc = wid & 3, fr = lane & 15, fq = lane >> 4;
    const int K = g.K, nt = K / BK;
    unsigned voffA[2], voffB[2];
#pragma unroll
    for (int i = 0; i < 2; ++i) { int R, C; stage_rc(tid * 16 + i * 8192, R, C); const int Rb = Epi::PERM ? ((R & ~31) + perm32(R & 31)) : R;
        voffA[i] = (unsigned)(R * K + C) * 2u; voffB[i] = (unsigned)(Rb * K + C) * 2u; }
    const size_t kstep = (size_t)(BK * 2);
    const size_t hstep = (size_t)HALF * K * 2;
    const size_t tstep = 2 * hstep;
    const unsigned ldsw = (unsigned)wid * 1024u;
    const int aoff = lds_byte(wr * 64 + fr, fq * 8), boff = lds_byte(wc * 32 + fr, fq * 8);
#define PG8_SA(b, h) (((b) * 2 + (h)) * HTB)
#define PG8_SB(b, h) ((4 + (b) * 2 + (h)) * HTB)
#define PG8_STAGE(bufoff, gbase, voff) do { _Pragma("unroll") for (int _i = 0; _i < 2; ++_i) \
        __builtin_amdgcn_global_load_lds((const unsigned*)((const char*)(gbase) + (voff)[_i]), (PG8_LAS unsigned*)(lds + (bufoff) + ldsw + _i * 8192), 16, 0, 0); } while (0)
#define PG8_LDA(dst, b, h) do { _Pragma("unroll") for (int m = 0; m < 4; ++m) _Pragma("unroll") for (int k = 0; k < 2; ++k) dst[m][k] = *(const PG8_LAS bf16x8*)(lds + PG8_SA(b, h) + aoff + m * 2048 + k * 1024); } while (0)
#define PG8_LDB(dst, b, h) do { _Pragma("unroll") for (int n = 0; n < 2; ++n) _Pragma("unroll") for (int k = 0; k < 2; ++k) dst[n][k] = *(const PG8_LAS bf16x8*)(lds + PG8_SB(b, h) + boff + n * 2048 + k * 1024); } while (0)
#define PG8_MMA(ai, bj, At, Bt) do { __builtin_amdgcn_s_setprio(1); _Pragma("unroll") for (int m = 0; m < 4; ++m) _Pragma("unroll") for (int n = 0; n < 2; ++n) _Pragma("unroll") for (int k = 0; k < 2; ++k) \
        acc[ai][bj][m][n] = __builtin_amdgcn_mfma_f32_16x16x32_bf16(Bt[n][k], At[m][k], acc[ai][bj][m][n], 0, 0, 0); __builtin_amdgcn_s_setprio(0); } while (0)
#define PG8_WAIT_V(n) asm volatile("s_waitcnt vmcnt(" #n ")" ::: "memory")
#define PG8_WAIT_L(n) asm volatile("s_waitcnt lgkmcnt(" #n ")" ::: "memory")
#define PG8_BAR __builtin_amdgcn_s_barrier()
#define PG8_SCHED __builtin_amdgcn_sched_barrier(0)
    Unit cur, nxt; int ui = 0;
    if (!S.next(0, cur)) return;
    f32x4 acc[2][2][4][2];
#pragma unroll
    for (int a = 0; a < 2; ++a)
#pragma unroll
        for (int b = 0; b < 2; ++b)
#pragma unroll
            for (int m = 0; m < 4; ++m)
#pragma unroll
                for (int n = 0; n < 2; ++n) acc[a][b][m][n] = (f32x4){0.f, 0.f, 0.f, 0.f};
    bf16x8 At[4][2], B0[2][2], B1[2][2];
    const char* cA = (const char*)g.A + (size_t)cur.pm * tstep; const char* cB = (const char*)g.Bt + (size_t)cur.pn * tstep;
    S.a_ready(cur);
    if constexpr (SP2) {
        PG8_STAGE(PG8_SB(0, 0), cB, voffB); PG8_STAGE(PG8_SB(0, 1), cB + hstep, voffB); PG8_STAGE(PG8_SA(0, 0), cA, voffA); PG8_STAGE(PG8_SA(0, 1), cA + hstep, voffA);
        if (wr == 1) PG8_BAR;
        PG8_WAIT_V(2); PG8_BAR;
        PG8_STAGE(PG8_SB(1, 0), cB + kstep, voffB); PG8_STAGE(PG8_SA(1, 0), cA + kstep, voffA); PG8_STAGE(PG8_SB(1, 1), cB + hstep + kstep, voffB);
        PG8_WAIT_V(6); PG8_BAR;
    } else {
        PG8_STAGE(PG8_SB(0, 0), cB, voffB); PG8_STAGE(PG8_SA(0, 0), cA, voffA); PG8_STAGE(PG8_SB(0, 1), cB + hstep, voffB); PG8_STAGE(PG8_SA(0, 1), cA + hstep, voffA);
        if (wr == 1) PG8_BAR;
        PG8_WAIT_V(4); PG8_BAR;
        PG8_STAGE(PG8_SB(1, 0), cB + kstep, voffB); PG8_STAGE(PG8_SA(1, 0), cA + kstep, voffA); PG8_STAGE(PG8_SB(1, 1), cB + hstep + kstep, voffB);
        PG8_WAIT_V(6); PG8_BAR;
    }
    for (;;) {
        const bool has_next = S.next(ui + 1, nxt);
        const char* nA = has_next ? (const char*)g.A + (size_t)nxt.pm * tstep : cA; const char* nB = has_next ? (const char*)g.Bt + (size_t)nxt.pn * tstep : cB;
        for (int t = 0; t < nt; t += 2) {
            const bool last = (t == nt - 2);
            const char* a1 = cA + (size_t)(t + 1) * kstep;
            const char* a2 = last ? nA : cA + (size_t)(t + 2) * kstep; const char* b2 = last ? nB : cB + (size_t)(t + 2) * kstep;
            const char* a3 = a2 + kstep; const char* b3 = b2 + kstep;
            if (last && has_next) S.a_ready(nxt);
            if constexpr (SP2) {
            PG8_LDB(B0, 0, 0); PG8_LDB(B1, 0, 1); PG8_SCHED; PG8_LDA(At, 0, 0); PG8_STAGE(PG8_SA(1, 1), a1 + hstep, voffA);
            PG8_WAIT_V(8); PG8_WAIT_L(0); PG8_BAR; PG8_MMA(0, 0, At, B0); PG8_MMA(0, 1, At, B1); PG8_BAR; PG8_SCHED;
            PG8_LDA(At, 0, 1); PG8_STAGE(PG8_SB(0, 0), b2, voffB); PG8_STAGE(PG8_SB(0, 1), b2 + hstep, voffB); PG8_STAGE(PG8_SA(0, 0), a2, voffA);
            PG8_WAIT_V(8); PG8_WAIT_L(0); PG8_BAR; PG8_MMA(1, 0, At, B0); PG8_MMA(1, 1, At, B1); PG8_BAR; PG8_SCHED;
            PG8_LDB(B0, 1, 0); PG8_LDB(B1, 1, 1); PG8_SCHED; PG8_LDA(At, 1, 0); PG8_STAGE(PG8_SA(0, 1), a2 + hstep, voffA);
            PG8_WAIT_V(8); PG8_WAIT_L(0); PG8_BAR; PG8_MMA(0, 0, At, B0); PG8_MMA(0, 1, At, B1); PG8_BAR; PG8_SCHED;
            PG8_LDA(At, 1, 1); PG8_STAGE(PG8_SB(1, 0), b3, voffB); PG8_STAGE(PG8_SB(1, 1), b3 + hstep, voffB); PG8_STAGE(PG8_SA(1, 0), a3, voffA);
            PG8_WAIT_V(8); PG8_WAIT_L(0); PG8_BAR; PG8_MMA(1, 0, At, B0); PG8_MMA(1, 1, At, B1); PG8_BAR; PG8_SCHED;
            } else {
            PG8_LDB(B0, 0, 0); PG8_SCHED; PG8_LDA(At, 0, 0); PG8_STAGE(PG8_SA(1, 1), a1 + hstep, voffA);
            PG8_WAIT_L(8); PG8_BAR; PG8_WAIT_L(0); PG8_MMA(0, 0, At, B0); PG8_BAR; PG8_SCHED;
            PG8_LDB(B1, 0, 1); PG8_STAGE(PG8_SB(0, 0), b2, voffB);
            PG8_BAR; PG8_WAIT_L(0); PG8_MMA(0, 1, At, B1); PG8_BAR;
            PG8_LDA(At, 0, 1); PG8_STAGE(PG8_SA(0, 0), a2, voffA);
            PG8_BAR; PG8_WAIT_L(0); PG8_MMA(1, 0, At, B0); PG8_BAR; PG8_SCHED;
            PG8_STAGE(PG8_SB(0, 1), b2 + hstep, voffB);
            PG8_WAIT_V(6); PG8_BAR; PG8_MMA(1, 1, At, B1); PG8_BAR;
            PG8_LDB(B0, 1, 0); PG8_SCHED; PG8_LDA(At, 1, 0); PG8_STAGE(PG8_SA(0, 1), a2 + hstep, voffA);
            PG8_WAIT_L(8); PG8_BAR; PG8_WAIT_L(0); PG8_MMA(0, 0, At, B0); PG8_BAR; PG8_SCHED;
            PG8_LDB(B1, 1, 1); PG8_STAGE(PG8_SB(1, 0), b3, voffB);
            PG8_BAR; PG8_WAIT_L(0); PG8_MMA(0, 1, At, B1); PG8_BAR;
            PG8_LDA(At, 1, 1); PG8_STAGE(PG8_SA(1, 0), a3, voffA);
            PG8_BAR; PG8_WAIT_L(0); PG8_MMA(1, 0, At, B0); PG8_BAR; PG8_SCHED;
            PG8_STAGE(PG8_SB(1, 1), b3 + hstep, voffB);
            PG8_WAIT_V(6); PG8_BAR; PG8_MMA(1, 1, At, B1); PG8_BAR;
            }
        }
        if constexpr (ALIGN_EPI) { if (wr == 0) PG8_BAR; }
        if constexpr (!Epi::AFTER_DRAIN) { E(acc, cur, wr, wc, fr, fq); S.done(cur); }
        if (!has_next) break;
#pragma unroll
        for (int a = 0; a < 2; ++a)
#pragma unroll
            for (int b = 0; b < 2; ++b)
#pragma unroll
                for (int m = 0; m < 4; ++m)
#pragma unroll
                    for (int n = 0; n < 2; ++n) acc[a][b][m][n] = (f32x4){0.f, 0.f, 0.f, 0.f};
        cur = nxt; cA = nA; cB = nB; ++ui;
        if constexpr (ALIGN_EPI) { if (wr == 1) PG8_BAR; }
    }
    PG8_WAIT_V(0);
    if constexpr (!ALIGN_EPI) { if (wr == 0) PG8_BAR; }
    PG8_BAR;
    if constexpr (Epi::AFTER_DRAIN) { E.fused(acc, cur, wr, wc, fr, fq, lds, wid, lane); S.done(cur); }
#undef PG8_SA
#undef PG8_SB
#undef PG8_STAGE
#undef PG8_LDA
#undef PG8_LDB
#undef PG8_MMA
#undef PG8_WAIT_V
#undef PG8_WAIT_L
#undef PG8_BAR
#undef PG8_SCHED
}
}
#define GAS __attribute__((address_space(1)))
#define LAS __attribute__((address_space(3)))
typedef unsigned short bf16;
typedef unsigned v4u __attribute__((ext_vector_type(4)));
typedef float f32x4 __attribute__((ext_vector_type(4)));
typedef short bf16x8 __attribute__((ext_vector_type(8)));
typedef GAS unsigned gu32;
typedef GAS unsigned long long gu64;
#define RLX_AGENT __ATOMIC_RELAXED, __HIP_MEMORY_SCOPE_AGENT
#define LDS_WAIT() asm volatile("s_waitcnt lgkmcnt(0)" ::: "memory")
#define VM_WAIT() asm volatile("s_waitcnt vmcnt(0)" ::: "memory")
__device__ __forceinline__ unsigned long long rt() { return __builtin_amdgcn_s_memrealtime(); }
__device__ __forceinline__ unsigned f2bf(float f) { unsigned u = __builtin_bit_cast(unsigned, f); return (u + 0x7fffu + ((u >> 16) & 1u)) >> 16; }
__device__ __forceinline__ unsigned pk2(float lo, float hi) { return f2bf(lo) | (f2bf(hi) << 16); }

#define XB_TMO      128
#define XB_XCNT(j)  (256  + 64 * (j))
#define XB_XSUB(j)  (1280 + 64 * (j))
#define XB_XGEN(j)  (2304 + 64 * (j))
#define XB_TOP      3328
#define XB_TOPGEN   3392
#define XCD_BAR_WORDS 3456
#define XB_SPIN_CAP (1u << 18)

__device__ __forceinline__ unsigned xb_ld(unsigned* p)              { return __hip_atomic_load(p, __ATOMIC_RELAXED, __HIP_MEMORY_SCOPE_AGENT); }
__device__ __forceinline__ unsigned xb_add(unsigned* p, unsigned v) { return __hip_atomic_fetch_add(p, v, __ATOMIC_RELAXED, __HIP_MEMORY_SCOPE_AGENT); }
__device__ __forceinline__ unsigned xb_xcc_id() { return (unsigned)__builtin_amdgcn_s_getreg((3 << 11) | 20) & 0xFu; }
#define XB_SPIN(cond, bar) do { unsigned _sp = 0; while (cond) { __builtin_amdgcn_s_sleep(1); \
    if ((++_sp & 255u) == 0u) { if (xb_ld(&(bar)[XB_TMO])) break; if (_sp > XB_SPIN_CAP) { atomicAdd(&(bar)[XB_TMO], 1u); break; } } } } while (0)

struct XcdBarrier {
    unsigned* bar; unsigned x;
    volatile LAS unsigned* st;
};

__device__ __forceinline__ XcdBarrier xcd_barrier_post(unsigned* bar, volatile LAS unsigned* st, int bwave) {
    XcdBarrier b; b.bar = bar; b.x = xb_xcc_id(); b.st = st;
    if (bwave == 0 && lane_id_asm() == 0) (void)xb_add(&bar[XB_XCNT(b.x)], 1u);
    return b;
}
__device__ __forceinline__ void xcd_barrier_complete(unsigned* bar, unsigned x, unsigned& nloc, unsigned& nx) {
    const unsigned G = gridDim.x * gridDim.y * gridDim.z;
    unsigned sum, cnt, mine, sp = 0u;
    for (;;) {
        sum = 0u; cnt = 0u; mine = 0u;
#pragma unroll
        for (unsigned j = 0; j < 16; ++j) { const unsigned c = xb_ld(&bar[XB_XCNT(j)]); sum += c; cnt += (c > 0u) ? 1u : 0u; mine = (j == x) ? c : mine; }
        if (sum == G) break;
        __builtin_amdgcn_s_sleep(1);
        if ((++sp & 255u) == 0u) { if (xb_ld(&bar[XB_TMO])) break; if (sp > XB_SPIN_CAP) { atomicAdd(&bar[XB_TMO], 1u); break; } }
    }
    nloc = mine > 0u ? mine : 1u; nx = cnt > 0u ? cnt : 1u;
}

__device__ __forceinline__ void xcd_barrier(const XcdBarrier& b, int bwave) {
    asm volatile("s_waitcnt vmcnt(0)" ::: "memory");
    __syncthreads();
    if (bwave == 0 && lane_id_asm() == 0) {
        unsigned* bar = b.bar;
        __builtin_amdgcn_s_waitcnt(0);
        unsigned nloc = b.st[0], nx = b.st[1];
        if (nloc == 0u) { xcd_barrier_complete(bar, b.x, nloc, nx); b.st[0] = nloc; b.st[1] = nx; }
        const unsigned old = xb_add(&bar[XB_XSUB(b.x)], 1u);
        const unsigned gen = old / nloc;
        if (old + 1u == (gen + 1u) * nloc) {
            __builtin_amdgcn_fence(__ATOMIC_RELEASE, "agent");
            asm volatile("s_waitcnt vmcnt(0)" ::: "memory");
            const unsigned og = xb_add(&bar[XB_TOP], 1u);
            const unsigned tg = og / nx;
            if (og + 1u == (tg + 1u) * nx) xb_add(&bar[XB_TOPGEN], 1u);
            else XB_SPIN(xb_ld(&bar[XB_TOPGEN]) == tg, bar);
            __builtin_amdgcn_fence(__ATOMIC_ACQUIRE, "agent");
            xb_add(&bar[XB_XGEN(b.x)], 1u);
            asm volatile("s_waitcnt vmcnt(0)" ::: "memory");
        } else {
            XB_SPIN(xb_ld(&bar[XB_XGEN(b.x)]) == gen, bar);
            __builtin_amdgcn_fence(__ATOMIC_ACQUIRE, "agent");
            asm volatile("s_waitcnt vmcnt(0)" ::: "memory");
        }
    }
    __syncthreads();
}

constexpr int DM = 1024, TSEQ = 8192, MPROMPT = 16384, NSAMP = 128, MTOK = 16512, MP = 16640, MA = MP + 512;
constexpr int PC = 3072;
constexpr int C_Q = 1792, C_K = 2304, C_V = 2432, C_XQ = 2560, ZC = 1792;
constexpr int NWAVES = 8;
constexpr int LDS_BYTES = 155648, MISC_OFF = LDS_BYTES - 512, WSZ = 17920;
constexpr size_t WS_CTL = 0, CTL_ZERO_BYTES = 1u << 20;
constexpr size_t WS_WIN = 1u << 20;
constexpr size_t WS_WBA = WS_WIN + (size_t)7168 * 1024 * 2;
constexpr size_t WS_WBB = WS_WBA + (size_t)1024 * 512 * 2;
constexpr size_t WS_WBC = WS_WBB + (size_t)1024 * 512 * 2;
constexpr size_t WS_WOUT = WS_WBC + (size_t)1024 * 512 * 2;
constexpr size_t WS_WUP = WS_WOUT + (size_t)1024 * 1024 * 2;
constexpr size_t WS_WDN = WS_WUP + (size_t)4096 * 1024 * 2;
constexpr size_t WS_W2T = WS_WDN + (size_t)4096 * 1024 * 2;
constexpr size_t WS_A2T = WS_W2T + 65536;
constexpr size_t WS_G2T = WS_A2T + 65536;
constexpr size_t WS_ROPE = WS_G2T + 131072;
constexpr size_t WS_SQ = WS_ROPE + (1u << 20);
constexpr size_t WS_XN = WS_SQ + (size_t)MP * 16 * 4;
constexpr size_t WS_KVB = WS_XN + (size_t)MA * 1024 * 2;
constexpr size_t WS_MRG = WS_KVB + (size_t)512 * 1024 * 2;
constexpr size_t WS_PROJ = WS_MRG + (size_t)MP * 1024 * 2;
constexpr size_t WS_OA = WS_PROJ + (size_t)MP * PC * 2;
constexpr size_t WS_OB = WS_OA + (size_t)MP * 512 * 2;
constexpr size_t WS_OC = WS_OB + (size_t)MP * 512 * 2;
constexpr size_t WS_END = WS_OC + (size_t)MP * 512 * 2;
constexpr size_t WS_GATE = WS_PROJ;
constexpr size_t WS_MACC = WS_PROJ + (size_t)MP * 1024 * 2;
constexpr size_t WS_H = WS_PROJ;
static_assert(WS_H + (size_t)MP * 4096 * 2 <= WS_END, "h overlay");
static_assert(WS_END <= 268435456, "d_ws map");
constexpr int CW_BAR = 4096;
constexpr size_t O_YP = 0, O_SP = 16908288, O_ZP = 16973824, O_KP = 16977408, O_VP = 17010176, O_MKP = 17042944, O_MVP = 17305088,
                 O_SS = 17567232, O_ZS = 21761536, O_KS = 21990912, O_VS = 24088064;

struct Params { const float* in[36]; float* out; unsigned char* ws; int never; int pad; };
enum { I_XP = 0, I_XS, I_SRW, I_SHIFT, I_CK, I_CV, I_CMK, I_CMV, I_MEM, I_NMIX, I_WIN, I_MU, I_W0, I_W2, I_A0, I_A2, I_G2, I_KK, I_KA, I_RK, I_LNW, I_LNB,
       I_QN, I_KN, I_SINK, I_MEMN, I_WMKV, I_XQN, I_XKN, I_WBA, I_WBB, I_WBC, I_WOUT, I_NFFN, I_WUP, I_WDN };

struct Frame {
    LAS unsigned char* lds; int wave, G, bid;
    const float* const* in; float* out; unsigned char* ws;
};
__device__ __forceinline__ float bf2f(unsigned short u) { return __builtin_bit_cast(float, (unsigned)u << 16); }
__device__ __forceinline__ float wave_sum(float v) {
#pragma unroll
    for (int o = 1; o < 64; o <<= 1) v += __shfl_xor(v, o);
    return v;
}
__device__ __forceinline__ float wave_max(float v) {
#pragma unroll
    for (int o = 1; o < 64; o <<= 1) v = fmaxf(v, __shfl_xor(v, o));
    return v;
}
__device__ __forceinline__ float dpp_xor1(float x) { return __builtin_bit_cast(float, __builtin_amdgcn_mov_dpp(__builtin_bit_cast(int, x), 0xB1, 0xF, 0xF, true)); }
__device__ __forceinline__ float dpp_xor2(float x) { return __builtin_bit_cast(float, __builtin_amdgcn_mov_dpp(__builtin_bit_cast(int, x), 0x4E, 0xF, 0xF, true)); }
__device__ __forceinline__ void unpack8(v4u w, float* x) {
    x[0] = __builtin_bit_cast(float, w.x << 16); x[1] = __builtin_bit_cast(float, w.x & 0xffff0000u);
    x[2] = __builtin_bit_cast(float, w.y << 16); x[3] = __builtin_bit_cast(float, w.y & 0xffff0000u);
    x[4] = __builtin_bit_cast(float, w.z << 16); x[5] = __builtin_bit_cast(float, w.z & 0xffff0000u);
    x[6] = __builtin_bit_cast(float, w.w << 16); x[7] = __builtin_bit_cast(float, w.w & 0xffff0000u);
}
__device__ __forceinline__ v4u pack8(const float* y) { v4u o; o.x = pk2(y[0], y[1]); o.y = pk2(y[2], y[3]); o.z = pk2(y[4], y[5]); o.w = pk2(y[6], y[7]); return o; }
__device__ __forceinline__ bf16x8 as_frag(v4u w) { return __builtin_bit_cast(bf16x8, w); }
#define MFMA16(a, b, c) __builtin_amdgcn_mfma_f32_16x16x32_bf16((a), (b), (c), 0, 0, 0)

__device__ __forceinline__ void tr_item(const float* W, int K, int N, bf16* WT, int row_off, LAS float* scr, int item, int lane, const float* kscale) {
    const int nblk = N / 32, kb = item / nblk, nb = item % nblk, k0 = 64 * kb, n0 = 32 * nb;
#pragma unroll 8
    for (int i = 0; i < 32; ++i) { const int kk = 2 * i + (lane >> 5); float v = W[(size_t)(k0 + kk) * N + n0 + (lane & 31)]; if (kscale) v *= kscale[k0 + kk]; scr[kk * 33 + (lane & 31)] = v; }
    LDS_WAIT(); asm volatile("" ::: "memory");
    const int c = lane & 7;
#pragma unroll
    for (int j = 0; j < 4; ++j) { const int n = (lane >> 3) + 8 * j; const LAS float* s = scr + (8 * c) * 33 + n;
        v4u o; o.x = pk2(s[0 * 33], s[1 * 33]); o.y = pk2(s[2 * 33], s[3 * 33]); o.z = pk2(s[4 * 33], s[5 * 33]); o.w = pk2(s[6 * 33], s[7 * 33]);
        *(GAS v4u*)(WT + (size_t)(row_off + n0 + n) * K + k0 + 8 * c) = o; }
    LDS_WAIT(); asm volatile("" ::: "memory");
}
__device__ __forceinline__ void rms_row_to_bf16(int lane, const float* xrow, const float* gain, bf16* orow) {
    const GAS f32x4* xr = (const GAS f32x4*)xrow + lane; const GAS f32x4* gr = (const GAS f32x4*)gain + lane;
    f32x4 v[4]; float s = 0.f;
#pragma unroll
    for (int j = 0; j < 4; ++j) { v[j] = xr[64 * j]; s += (v[j].x * v[j].x + v[j].y * v[j].y) + (v[j].z * v[j].z + v[j].w * v[j].w); }
    const float rstd = 1.f / sqrtf(wave_sum(s) * (1.f / 1024.f) + 1e-5f);
    GAS unsigned long long* o8 = (GAS unsigned long long*)orow + lane;
#pragma unroll
    for (int j = 0; j < 4; ++j) { const f32x4 g = gr[64 * j];
        o8[64 * j] = (unsigned long long)pk2(v[j].x * rstd * g.x, v[j].y * rstd * g.y) | ((unsigned long long)pk2(v[j].z * rstd * g.z, v[j].w * rstd * g.w) << 32); }
}
__constant__ double ROPE_INVF[8] = {1.0, 0.19392274474868576, 0.03760603093086393, 0.007292664737217109, 0.001414213562373095, 0.0002742481756762073, 5.318295896944988e-05, 1.031338537721246e-05};
__device__ __forceinline__ void p0_prologue(Frame& F) {
    LAS float* scr = (LAS float*)(F.lds + F.wave * 16384);
    const int gw = F.bid * NWAVES + F.wave, NGW = F.G * NWAVES;
    unsigned char* ws = F.ws;
    constexpr int I0 = 16 * 192, I1 = 16 * 32, I2 = 8 * 32, I3 = 16 * 32, I4 = 16 * 128, I5 = 64 * 32, I6 = 16, I7 = 32;
    constexpr int NITEMS = I0 + I1 + 3 * I2 + I3 + I4 + I5 + 2 * I6 + I7;
    for (int it = gw; it < NITEMS; it += NGW) {
        int r = it;
        if (r < I0) { tr_item(F.in[I_WIN], 1024, 6144, (bf16*)(ws + WS_WIN), 0, scr, r, lane_id_asm(), nullptr); continue; } r -= I0;
        if (r < I1) { tr_item(F.in[I_WMKV], 1024, 1024, (bf16*)(ws + WS_WIN), 6144, scr, r, lane_id_asm(), nullptr); continue; } r -= I1;
        if (r < I2) { tr_item(F.in[I_WBA], 512, 1024, (bf16*)(ws + WS_WBA), 0, scr, r, lane_id_asm(), nullptr); continue; } r -= I2;
        if (r < I2) { tr_item(F.in[I_WBB], 512, 1024, (bf16*)(ws + WS_WBB), 0, scr, r, lane_id_asm(), nullptr); continue; } r -= I2;
        if (r < I2) { tr_item(F.in[I_WBC], 512, 1024, (bf16*)(ws + WS_WBC), 0, scr, r, lane_id_asm(), nullptr); continue; } r -= I2;
        if (r < I3) { tr_item(F.in[I_WOUT], 1024, 1024, (bf16*)(ws + WS_WOUT), 0, scr, r, lane_id_asm(), nullptr); continue; } r -= I3;
        if (r < I4) { tr_item(F.in[I_WUP], 1024, 4096, (bf16*)(ws + WS_WUP), 0, scr, r, lane_id_asm(), F.in[I_NFFN]); continue; } r -= I4;
        if (r < I5) { tr_item(F.in[I_WDN], 4096, 1024, (bf16*)(ws + WS_WDN), 0, scr, r, lane_id_asm(), nullptr); continue; } r -= I5;
        if (r < I6) { tr_item(F.in[I_W2], 64, 512, (bf16*)(ws + WS_W2T), 0, scr, r, lane_id_asm(), nullptr); continue; } r -= I6;
        if (r < I6) { tr_item(F.in[I_A2], 64, 512, (bf16*)(ws + WS_A2T), 0, scr, r, lane_id_asm(), nullptr); continue; } r -= I6;
        tr_item(F.in[I_G2], 128, 512, (bf16*)(ws + WS_G2T), 0, scr, r, lane_id_asm(), nullptr);
    }
    bf16* XN = (bf16*)(ws + WS_XN);
    for (int m = gw; m < MA; m += NGW) {
        if (m < MPROMPT) rms_row_to_bf16(lane_id_asm(), F.in[I_XP] + (size_t)m * DM, F.in[I_NMIX], XN + (size_t)m * DM);
        else if (m < MTOK) rms_row_to_bf16(lane_id_asm(), F.in[I_XS] + (size_t)(m - MPROMPT) * DM, F.in[I_NMIX], XN + (size_t)m * DM);
        else if (m < MP) { GAS v4u* o = (GAS v4u*)(XN + (size_t)m * DM) + lane_id_asm(); o[0] = (v4u){0, 0, 0, 0}; o[64] = (v4u){0, 0, 0, 0}; }
        else rms_row_to_bf16(lane_id_asm(), F.in[I_MEM] + (size_t)(m - MP) * DM, F.in[I_MEMN], XN + (size_t)m * DM);
    }
    float* rope = (float*)(ws + WS_ROPE);
    for (int e = F.bid * 512 + (F.wave * 64 + lane_id_asm()); e < 8193 * 8; e += F.G * 512) {
        const int pos = e >> 3, i = e & 7; const double a = (double)pos * ROPE_INVF[i];
        const double n = __builtin_rint(a * 0.15915494309189535); const float r = (float)(a - n * 6.283185307179586);
        rope[pos * 16 + i] = cosf(r); rope[pos * 16 + 8 + i] = sinf(r);
    }
}

struct P1Order {
    pg8::StaticOrder so;
    __device__ bool next(int i, pg8::Unit& u) const {
        long L = (long)i * so.G + so.c; if (L < so.nwg) return so.next(i, u);
        L -= so.nwg; if (L >= 8) return false; u.pm = 65 + (int)(L >> 2); u.pn = 24 + (int)(L & 3); return true;
    }
    __device__ __forceinline__ void a_ready(const pg8::Unit&) const {}
    __device__ __forceinline__ void done(const pg8::Unit&) const {}
};
using pg8::f32x4; using pg8::u32x4; using pg8::HALF; using pg8::BM;
#define EPI_LOOP_BEGIN  _Pragma("unroll") for (int ai = 0; ai < 2; ++ai) _Pragma("unroll") for (int m = 0; m < 4; ++m) { const int row = u.pm * BM + wr * 64 + fr + ai * HALF + m * 16; \
                        _Pragma("unroll") for (int bj = 0; bj < 2; ++bj) { const int col = u.pn * BM + wc * 32 + 8 * fq + bj * HALF; f32x4 v0 = acc[ai][bj][m][0], v1 = acc[ai][bj][m][1];
#define EPI_LOOP_END    } }
__device__ __forceinline__ u32x4 pack_acc(f32x4 v0, f32x4 v1) { u32x4 w; w.x = pg8::cvt_pk_bf16(v0[0], v0[1]); w.y = pg8::cvt_pk_bf16(v0[2], v0[3]); w.z = pg8::cvt_pk_bf16(v1[0], v1[1]); w.w = pg8::cvt_pk_bf16(v1[2], v1[3]); return w; }
struct EpiP1 {
    static constexpr bool PERM = true, AFTER_DRAIN = false;
    pg8::bf16_t* proj; pg8::bf16_t* kvb;
    __device__ __forceinline__ void operator()(const f32x4 (&acc)[2][2][4][2], const pg8::Unit& u, int wr, int wc, int fr, int fq) const {
        const bool memu = u.pm >= 65;
        EPI_LOOP_BEGIN
            const u32x4 w = pack_acc(v0, v1);
            if (memu) *(u32x4*)(kvb + (size_t)(row - 65 * BM) * 1024 + (col - 24 * BM)) = w;
            else *(u32x4*)(proj + (size_t)row * PC + col) = w;
        EPI_LOOP_END
    }
};
struct EpiGate {
    static constexpr bool PERM = true, AFTER_DRAIN = false;
    pg8::bf16_t* gate;
    __device__ __forceinline__ void operator()(const f32x4 (&acc)[2][2][4][2], const pg8::Unit& u, int wr, int wc, int fr, int fq) const {
        EPI_LOOP_BEGIN
#pragma unroll
            for (int e = 0; e < 4; ++e) { v0[e] = 1.f / (1.f + __expf(-v0[e])); v1[e] = 1.f / (1.f + __expf(-v1[e])); }
            *(u32x4*)(gate + (size_t)row * 1024 + col) = pack_acc(v0, v1);
        EPI_LOOP_END
    }
};
template <int MODE> struct EpiBr {
    static constexpr bool PERM = true, AFTER_DRAIN = false;
    const pg8::bf16_t* gate; float* macc; pg8::bf16_t* mrg;
    __device__ __forceinline__ void operator()(const f32x4 (&acc)[2][2][4][2], const pg8::Unit& u, int wr, int wc, int fr, int fq) const {
        EPI_LOOP_BEGIN
            const u32x4 gw = *(const u32x4*)(gate + (size_t)row * 1024 + col);
            float g[8]; unpack8((v4u){gw.x, gw.y, gw.z, gw.w}, g);
            float* mp = macc + (size_t)row * 1024 + col;
            f32x4 a0 = (f32x4){g[0], g[1], g[2], g[3]} * v0, a1 = (f32x4){g[4], g[5], g[6], g[7]} * v1;
            if (MODE >= 1) { a0 += *(const f32x4*)mp; a1 += *(const f32x4*)(mp + 4); }
            if (MODE <= 1) { *(f32x4*)mp = a0; *(f32x4*)(mp + 4) = a1; }
            else *(u32x4*)(mrg + (size_t)row * 1024 + col) = pack_acc(a0, a1);
        EPI_LOOP_END
    }
};
struct EpiOut {
    static constexpr bool PERM = true, AFTER_DRAIN = false;
    const float* xp; const float* xs; float* out; pg8::bf16_t* x1b; float* sq;
    __device__ __forceinline__ void operator()(const f32x4 (&acc)[2][2][4][2], const pg8::Unit& u, int wr, int wc, int fr, int fq) const {
#pragma unroll
        for (int ai = 0; ai < 2; ++ai)
#pragma unroll
            for (int m = 0; m < 4; ++m) { const int row = u.pm * BM + wr * 64 + fr + ai * HALF + m * 16; float ss = 0.f;
                const float* xr = row < MPROMPT ? xp + (size_t)row * DM : xs + (size_t)(row - MPROMPT) * DM;
#pragma unroll
                for (int bj = 0; bj < 2; ++bj) { const int col = u.pn * BM + wc * 32 + 8 * fq + bj * HALF; f32x4 v0 = acc[ai][bj][m][0], v1 = acc[ai][bj][m][1];
                    if (row < MTOK) { v0 += *(const f32x4*)(xr + col); v1 += *(const f32x4*)(xr + col + 4);
                        *(f32x4*)(out + (size_t)row * DM + col) = v0; *(f32x4*)(out + (size_t)row * DM + col + 4) = v1; }
                    else { v0 = (f32x4){0.f, 0.f, 0.f, 0.f}; v1 = v0; }
                    ss += (v0[0] * v0[0] + v0[1] * v0[1]) + (v0[2] * v0[2] + v0[3] * v0[3]) + (v1[0] * v1[0] + v1[1] * v1[1]) + (v1[2] * v1[2] + v1[3] * v1[3]);
                    *(u32x4*)(x1b + (size_t)row * DM + col) = pack_acc(v0, v1); }
                ss += __shfl_xor(ss, 16); ss += __shfl_xor(ss, 32);
                if (fq == 0) sq[(size_t)row * 16 + u.pn * 4 + wc] = ss; }
    }
};
struct EpiUp {
    static constexpr bool PERM = true, AFTER_DRAIN = false;
    const float* sq; pg8::bf16_t* h;
    __device__ __forceinline__ void operator()(const f32x4 (&acc)[2][2][4][2], const pg8::Unit& u, int wr, int wc, int fr, int fq) const {
#pragma unroll
        for (int ai = 0; ai < 2; ++ai)
#pragma unroll
            for (int m = 0; m < 4; ++m) { const int row = u.pm * BM + wr * 64 + fr + ai * HALF + m * 16;
                const f32x4* sp = (const f32x4*)(sq + (size_t)row * 16); const f32x4 s0 = sp[0], s1 = sp[1], s2 = sp[2], s3 = sp[3];
                const float tot = ((s0[0] + s0[1]) + (s0[2] + s0[3])) + ((s1[0] + s1[1]) + (s1[2] + s1[3])) + ((s2[0] + s2[1]) + (s2[2] + s2[3])) + ((s3[0] + s3[1]) + (s3[2] + s3[3]));
                const float rstd = 1.f / sqrtf(tot * (1.f / 1024.f) + 1e-5f);
#pragma unroll
                for (int bj = 0; bj < 2; ++bj) { const int col = u.pn * BM + wc * 32 + 8 * fq + bj * HALF; f32x4 v0 = acc[ai][bj][m][0] * rstd, v1 = acc[ai][bj][m][1] * rstd;
#pragma unroll
                    for (int e = 0; e < 4; ++e) { const float a = fmaxf(v0[e], 0.f), b = fmaxf(v1[e], 0.f); v0[e] = a * a; v1[e] = b * b; }
                    *(u32x4*)(h + (size_t)row * 4096 + col) = pack_acc(v0, v1); } }
    }
};
struct EpiDown {
    static constexpr bool PERM = true, AFTER_DRAIN = false;
    float* out;
    __device__ __forceinline__ void operator()(const f32x4 (&acc)[2][2][4][2], const pg8::Unit& u, int wr, int wc, int fr, int fq) const {
        EPI_LOOP_BEGIN
            if (row < MTOK) { float* op = out + (size_t)row * DM + col; const f32x4 a0 = *(const f32x4*)op + v0, a1 = *(const f32x4*)(op + 4) + v1; *(f32x4*)op = a0; *(f32x4*)(op + 4) = a1; }
        EPI_LOOP_END
    }
};

__device__ __forceinline__ void swa_unit(Frame& F, int b, int kvh, int qb) {
    LAS bf16* Ks = (LAS bf16*)F.lds; LAS bf16* Vt = Ks + 256 * 72;
    const bf16* proj = (const bf16*)(F.ws + WS_PROJ); const float* rope = (const float*)(F.ws + WS_ROPE);
    const int tid = (F.wave * 64 + lane_id_asm()), lane = lane_id_asm();
    {   const int sub = tid & 7; float gn[8];
#pragma unroll
        for (int j = 0; j < 8; ++j) gn[j] = F.in[I_KN][8 * sub + j];
        for (int pass = 0; pass < 4; ++pass) {
            const int kk = pass * 64 + (tid >> 3), tk = 128 * (qb - 1) + kk; const bool valid = tk >= 0; const size_t m = (size_t)b * TSEQ + (valid ? tk : 0);
            float x[8], vv[8]; unpack8(*(const v4u*)(proj + m * PC + C_K + 64 * kvh + 8 * sub), x); unpack8(*(const v4u*)(proj + m * PC + C_V + 64 * kvh + 8 * sub), vv);
            float ss = 0.f;
#pragma unroll
            for (int j = 0; j < 8; ++j) ss += x[j] * x[j];
            ss += __shfl_xor(ss, 1); ss += __shfl_xor(ss, 2); ss += __shfl_xor(ss, 4);
            const float rstd = 1.f / sqrtf(ss * (1.f / 64.f) + 1e-5f);
            const float* rp = rope + (size_t)(valid ? tk : 0) * 16;
#pragma unroll
            for (int j = 0; j < 8; ++j) { x[j] = x[j] * rstd * gn[j]; const float other = __shfl_xor(x[j], 1); const float c = rp[j], s = rp[8 + j];
                if (sub == 0) x[j] = x[j] * c - other * s; else if (sub == 1) x[j] = x[j] * c + other * s; }
            if (!valid) {
#pragma unroll
                for (int j = 0; j < 8; ++j) { x[j] = 0.f; vv[j] = 0.f; } }
            *(LAS v4u*)(Ks + kk * 72 + 8 * sub) = pack8(x);
#pragma unroll
            for (int j = 0; j < 8; ++j) Vt[(8 * sub + j) * 264 + kk] = (bf16)f2bf(vv[j]);
            if (qb == 63 && kk >= 128) { const size_t o = ((size_t)(b * 128 + (kk - 128)) * 2 + kvh) * 64 + 8 * sub;
#pragma unroll
                for (int j = 0; j < 8; ++j) { F.out[O_KP + o + j] = x[j]; F.out[O_VP + o + j] = vv[j]; } }
        }
    }
    __syncthreads();
    const int q = lane & 15, gq = lane >> 4;
    bf16* ob = (bf16*)(F.ws + WS_OB);
    for (int mi = 0; mi < 4; ++mi) {
        const int mt = F.wave * 4 + mi, g = mt >> 3, tb = mt & 7, head = 4 * kvh + g;
        const int qi = 16 * tb + q, tq = 128 * qb + qi; const size_t m = (size_t)b * TSEQ + tq;
        float x0[8], x1[8]; unpack8(*(const v4u*)(proj + m * PC + C_Q + 64 * head + 8 * gq), x0); unpack8(*(const v4u*)(proj + m * PC + C_Q + 64 * head + 32 + 8 * gq), x1);
        float ss = 0.f;
#pragma unroll
        for (int j = 0; j < 8; ++j) ss += x0[j] * x0[j] + x1[j] * x1[j];
        ss += __shfl_xor(ss, 16); ss += __shfl_xor(ss, 32);
        const float rstd = 0.125f / sqrtf(ss * (1.f / 64.f) + 1e-5f);
        const float* rp = rope + (size_t)tq * 16;
#pragma unroll
        for (int j = 0; j < 8; ++j) { x0[j] = x0[j] * rstd * F.in[I_QN][8 * gq + j]; x1[j] = x1[j] * rstd * F.in[I_QN][32 + 8 * gq + j];
            const float other = __shfl_xor(x0[j], 16); const float c = rp[j], s = rp[8 + j];
            if (gq == 0) x0[j] = x0[j] * c - other * s; else if (gq == 1) x0[j] = x0[j] * c + other * s; }
        const bf16x8 qf0 = as_frag(pack8(x0)), qf1 = as_frag(pack8(x1));
        f32x4 acc[10];
#pragma unroll
        for (int kt = 0; kt < 9; ++kt) { const LAS bf16* kp = Ks + (16 * (tb + kt) + q) * 72 + 8 * gq;
            f32x4 a = (f32x4){0.f, 0.f, 0.f, 0.f};
            a = MFMA16(*(const LAS bf16x8*)kp, qf0, a); a = MFMA16(*(const LAS bf16x8*)(kp + 32), qf1, a); acc[kt] = a; __builtin_amdgcn_sched_barrier(0); }
        acc[9] = (f32x4){0.f, 0.f, 0.f, 0.f};
        const float sink = F.in[I_SINK][head]; float mx = sink;
#pragma unroll
        for (int kt = 0; kt < 9; ++kt)
#pragma unroll
            for (int r = 0; r < 4; ++r) { const int kk = 16 * (tb + kt) + 4 * gq + r; const bool ok = kk >= qi && kk <= qi + 128 && (qb > 0 || kk >= 128);
                acc[kt][r] = ok ? acc[kt][r] : -INFINITY; mx = fmaxf(mx, acc[kt][r]); }
        mx = fmaxf(mx, __shfl_xor(mx, 16)); mx = fmaxf(mx, __shfl_xor(mx, 32));
        float ls = 0.f;
#pragma unroll
        for (int kt = 0; kt < 9; ++kt)
#pragma unroll
            for (int r = 0; r < 4; ++r) { const float p = __expf(acc[kt][r] - mx); acc[kt][r] = p; ls += p; }
        ls += __shfl_xor(ls, 16); ls += __shfl_xor(ls, 32); ls += __expf(sink - mx);
        f32x4 o[4];
#pragma unroll
        for (int dt = 0; dt < 4; ++dt) o[dt] = (f32x4){0.f, 0.f, 0.f, 0.f};
#pragma unroll
        for (int s = 0; s < 5; ++s) {
            v4u pw; pw.x = pk2(acc[2 * s][0], acc[2 * s][1]); pw.y = pk2(acc[2 * s][2], acc[2 * s][3]); pw.z = pk2(acc[2 * s + 1][0], acc[2 * s + 1][1]); pw.w = pk2(acc[2 * s + 1][2], acc[2 * s + 1][3]);
            const bf16x8 pf = as_frag(pw);
            const int t0 = tb + 2 * s, t1 = (t0 + 1 <= 15) ? t0 + 1 : 15;
#pragma unroll
            for (int dt = 0; dt < 4; ++dt) { const LAS bf16* vp = Vt + (16 * dt + q) * 264 + 4 * gq;
                typedef unsigned u32x2 __attribute__((ext_vector_type(2)));
                const u32x2 lo = *(const LAS u32x2*)(vp + 16 * t0), hi = *(const LAS u32x2*)(vp + 16 * t1);
                o[dt] = MFMA16(as_frag((v4u){lo.x, lo.y, hi.x, hi.y}), pf, o[dt]); }
            __builtin_amdgcn_sched_barrier(0);
        }
        const float il = 1.f / ls;
#pragma unroll
        for (int dt = 0; dt < 4; ++dt) { typedef unsigned u32x2 __attribute__((ext_vector_type(2)));
            u32x2 w; w.x = pk2(o[dt][0] * il, o[dt][1] * il); w.y = pk2(o[dt][2] * il, o[dt][3] * il);
            *(u32x2*)(ob + m * 512 + 64 * head + 16 * dt + 4 * gq) = w; }
    }
    __syncthreads();
}

__device__ __forceinline__ void mem_unit(Frame& F, int b, int hm, int tb) {
    LAS bf16* Km = (LAS bf16*)F.lds; LAS bf16* Vt = Km + 256 * 136;
    const bf16* proj = (const bf16*)(F.ws + WS_PROJ); const bf16* kvb = (const bf16*)(F.ws + WS_KVB);
    const int tid = (F.wave * 64 + lane_id_asm()), lane = lane_id_asm();
    {   const int sub = tid & 15; float gn[8];
#pragma unroll
        for (int j = 0; j < 8; ++j) gn[j] = F.in[I_XKN][8 * sub + j];
        for (int pass = 0; pass < 8; ++pass) {
            const int mm = pass * 32 + (tid >> 4); const size_t r = (size_t)(b * 256 + mm) * 1024 + 128 * hm + 8 * sub;
            float x[8], vv[8]; unpack8(*(const v4u*)(kvb + r), x); unpack8(*(const v4u*)(kvb + r + 512), vv);
            float ss = 0.f;
#pragma unroll
            for (int j = 0; j < 8; ++j) ss += x[j] * x[j];
            ss += __shfl_xor(ss, 1); ss += __shfl_xor(ss, 2); ss += __shfl_xor(ss, 4); ss += __shfl_xor(ss, 8);
            const float rstd = 1.f / sqrtf(ss * (1.f / 128.f) + 1e-5f);
#pragma unroll
            for (int j = 0; j < 8; ++j) x[j] = x[j] * rstd * gn[j];
            *(LAS v4u*)(Km + mm * 136 + 8 * sub) = pack8(x);
#pragma unroll
            for (int j = 0; j < 8; ++j) Vt[(8 * sub + j) * 264 + mm] = (bf16)f2bf(vv[j]);
            if (tb == 0) { const size_t o = ((size_t)(b * 256 + mm) * 4 + hm) * 128 + 8 * sub;
#pragma unroll
                for (int j = 0; j < 8; ++j) { F.out[O_MKP + o + j] = x[j]; F.out[O_MVP + o + j] = vv[j]; } }
        }
    }
    __syncthreads();
    const int q = lane & 15, gq = lane >> 4;
    bf16* oc = (bf16*)(F.ws + WS_OC);
    for (int mi = 0; mi < 2; ++mi) {
        const int mt = F.wave * 2 + mi; const size_t m = (size_t)b * TSEQ + 256 * tb + 16 * mt + q;
        bf16x8 qf[4];
        {   float x[4][8]; float ss = 0.f;
#pragma unroll
            for (int ks = 0; ks < 4; ++ks) { unpack8(*(const v4u*)(proj + m * PC + C_XQ + 128 * hm + 32 * ks + 8 * gq), x[ks]);
#pragma unroll
                for (int j = 0; j < 8; ++j) ss += x[ks][j] * x[ks][j]; }
            ss += __shfl_xor(ss, 16); ss += __shfl_xor(ss, 32);
            const float rstd = 0.08838834764831845f / sqrtf(ss * (1.f / 128.f) + 1e-5f);
#pragma unroll
            for (int ks = 0; ks < 4; ++ks) {
#pragma unroll
                for (int j = 0; j < 8; ++j) x[ks][j] = x[ks][j] * rstd * F.in[I_XQN][32 * ks + 8 * gq + j];
                qf[ks] = as_frag(pack8(x[ks])); }
        }
        f32x4 acc[16]; float mx = -INFINITY;
#pragma unroll
        for (int kt = 0; kt < 16; ++kt) { const LAS bf16* kp = Km + (16 * kt + q) * 136 + 8 * gq; f32x4 a = (f32x4){0.f, 0.f, 0.f, 0.f};
#pragma unroll
            for (int ks = 0; ks < 4; ++ks) a = MFMA16(*(const LAS bf16x8*)(kp + 32 * ks), qf[ks], a);
            acc[kt] = a; mx = fmaxf(mx, fmaxf(fmaxf(a[0], a[1]), fmaxf(a[2], a[3]))); __builtin_amdgcn_sched_barrier(0); }
        mx = fmaxf(mx, __shfl_xor(mx, 16)); mx = fmaxf(mx, __shfl_xor(mx, 32));
        float ls = 0.f;
#pragma unroll
        for (int kt = 0; kt < 16; ++kt)
#pragma unroll
            for (int r = 0; r < 4; ++r) { const float p = __expf(acc[kt][r] - mx); acc[kt][r] = p; ls += p; }
        ls += __shfl_xor(ls, 16); ls += __shfl_xor(ls, 32);
        f32x4 o[8];
#pragma unroll
        for (int dt = 0; dt < 8; ++dt) o[dt] = (f32x4){0.f, 0.f, 0.f, 0.f};
#pragma unroll
        for (int s = 0; s < 8; ++s) {
            v4u pw; pw.x = pk2(acc[2 * s][0], acc[2 * s][1]); pw.y = pk2(acc[2 * s][2], acc[2 * s][3]); pw.z = pk2(acc[2 * s + 1][0], acc[2 * s + 1][1]); pw.w = pk2(acc[2 * s + 1][2], acc[2 * s + 1][3]);
            const bf16x8 pf = as_frag(pw);
#pragma unroll
            for (int dt = 0; dt < 8; ++dt) { const LAS bf16* vp = Vt + (16 * dt + q) * 264 + 32 * s + 4 * gq;
                typedef unsigned u32x2 __attribute__((ext_vector_type(2)));
                const u32x2 lo = *(const LAS u32x2*)vp, hi = *(const LAS u32x2*)(vp + 16);
                o[dt] = MFMA16(as_frag((v4u){lo.x, lo.y, hi.x, hi.y}), pf, o[dt]); }
            __builtin_amdgcn_sched_barrier(0);
        }
        const float il = 1.f / ls;
#pragma unroll
        for (int dt = 0; dt < 8; ++dt) { typedef unsigned u32x2 __attribute__((ext_vector_type(2)));
            u32x2 w; w.x = pk2(o[dt][0] * il, o[dt][1] * il); w.y = pk2(o[dt][2] * il, o[dt][3] * il);
            *(u32x2*)(oc + m * 512 + 128 * hm + 16 * dt + 4 * gq) = w; }
    }
    __syncthreads();
}

__device__ __forceinline__ void swa_sample_task(Frame& F, LAS float* wl, int bs) {
    int lane = lane_id_asm(); asm volatile("" : "+v"(lane)); const size_t m = MPROMPT + bs;
    const bf16* prow = (const bf16*)(F.ws + WS_PROJ) + m * PC; const float* rp = (const float*)(F.ws + WS_ROPE) + (size_t)8192 * 16;
    LAS float* qs = wl;
    LAS float* kn = wl + 512;
    LAS float* vn = wl + 640;
    LAS float* pp = wl + 768;
    const float* ck = F.in[I_CK] + (size_t)bs * 16384; const float* cv = F.in[I_CV] + (size_t)bs * 16384;
    float* ok = F.out + O_KS + (size_t)bs * 16384; float* ov = F.out + O_VS + (size_t)bs * 16384;
    const float c = rp[lane & 7], s = rp[8 + (lane & 7)];
    for (int h = 0; h < 10; ++h) {
        const float x = bf2f(h < 8 ? prow[C_Q + 64 * h + lane] : prow[C_K + 64 * (h - 8) + lane]);
        const float rstd = 1.f / sqrtf(wave_sum(x * x) * (1.f / 64.f) + 1e-5f);
        float y = x * rstd * (h < 8 ? F.in[I_QN][lane] : F.in[I_KN][lane]);
        const float other = __shfl_xor(y, 8);
        if (lane < 8) y = y * c - other * s; else if (lane < 16) y = y * c + other * s;
        if (h < 8) qs[64 * h + lane] = y * 0.125f; else { kn[64 * (h - 8) + lane] = y; ok[127 * 128 + 64 * (h - 8) + lane] = y; }
    }
    for (int kvh = 0; kvh < 2; ++kvh) { const float v = bf2f(prow[C_V + 64 * kvh + lane]); vn[64 * kvh + lane] = v; ov[127 * 128 + 64 * kvh + lane] = v; }
    for (int i = lane; i < 127 * 32; i += 64) { ((f32x4*)ok)[i] = ((const f32x4*)ck)[i + 32]; ((f32x4*)ov)[i] = ((const f32x4*)cv)[i + 32]; }
    float sc[2][8];
#pragma unroll
    for (int ps = 0; ps < 2; ++ps) { const float* kr = ck + (size_t)(lane + 64 * ps) * 128;
#pragma unroll
        for (int kvh = 0; kvh < 2; ++kvh) { float a0 = 0.f, a1 = 0.f, a2 = 0.f, a3 = 0.f;
#pragma unroll 2
            for (int d4 = 0; d4 < 16; ++d4) { const f32x4 k4 = *(const f32x4*)(kr + 64 * kvh + 4 * d4);
                const f32x4 q0 = *(const LAS f32x4*)(qs + 64 * (4 * kvh) + 4 * d4), q1 = *(const LAS f32x4*)(qs + 64 * (4 * kvh + 1) + 4 * d4), q2 = *(const LAS f32x4*)(qs + 64 * (4 * kvh + 2) + 4 * d4), q3 = *(const LAS f32x4*)(qs + 64 * (4 * kvh + 3) + 4 * d4);
                a0 += k4[0] * q0[0] + k4[1] * q0[1] + k4[2] * q0[2] + k4[3] * q0[3]; a1 += k4[0] * q1[0] + k4[1] * q1[1] + k4[2] * q1[2] + k4[3] * q1[3];
                a2 += k4[0] * q2[0] + k4[1] * q2[1] + k4[2] * q2[2] + k4[3] * q2[3]; a3 += k4[0] * q3[0] + k4[1] * q3[1] + k4[2] * q3[2] + k4[3] * q3[3]; }
            sc[ps][4 * kvh] = a0; sc[ps][4 * kvh + 1] = a1; sc[ps][4 * kvh + 2] = a2; sc[ps][4 * kvh + 3] = a3; } }
    float linv[8];
#pragma unroll
    for (int h = 0; h < 8; ++h) {
        const float sn = wave_sum(qs[64 * h + lane] * kn[64 * (h >> 2) + lane]); const float sink = F.in[I_SINK][h];
        const float mx = fmaxf(fmaxf(wave_max(fmaxf(sc[0][h], sc[1][h])), sn), sink);
        const float p0 = __expf(sc[0][h] - mx), p1 = __expf(sc[1][h] - mx), pn = __expf(sn - mx);
        const float l = wave_sum(p0 + p1) + pn + __expf(sink - mx);
        pp[132 * h + lane] = p0; pp[132 * h + 64 + lane] = p1; if (lane == 0) pp[132 * h + 128] = pn; linv[h] = 1.f / l;
    }
    bf16* ob = (bf16*)(F.ws + WS_OB) + m * 512;
#pragma unroll
    for (int kvh = 0; kvh < 2; ++kvh) { float o0 = 0.f, o1 = 0.f, o2 = 0.f, o3 = 0.f;
#pragma unroll 4
        for (int key = 0; key < 129; ++key) { const float v = key < 128 ? cv[(size_t)key * 128 + 64 * kvh + lane] : vn[64 * kvh + lane];
            o0 += pp[132 * (4 * kvh) + key] * v; o1 += pp[132 * (4 * kvh + 1) + key] * v; o2 += pp[132 * (4 * kvh + 2) + key] * v; o3 += pp[132 * (4 * kvh + 3) + key] * v; }
        ob[64 * (4 * kvh) + lane] = (bf16)f2bf(o0 * linv[4 * kvh]); ob[64 * (4 * kvh + 1) + lane] = (bf16)f2bf(o1 * linv[4 * kvh + 1]);
        ob[64 * (4 * kvh + 2) + lane] = (bf16)f2bf(o2 * linv[4 * kvh + 2]); ob[64 * (4 * kvh + 3) + lane] = (bf16)f2bf(o3 * linv[4 * kvh + 3]); }
}
__device__ __forceinline__ void mem_sample_task(Frame& F, LAS float* wl, int bs, int hm) {
    int lane = lane_id_asm(); asm volatile("" : "+v"(lane)); const size_t m = MPROMPT + bs;
    const bf16* prow = (const bf16*)(F.ws + WS_PROJ) + m * PC;
    LAS float* sc = wl;
    const int half = lane >> 5, d4 = 4 * (lane & 31);
    float q4[4];
    {   float x[4]; float ss = 0.f;
#pragma unroll
        for (int e = 0; e < 4; ++e) { x[e] = bf2f(prow[C_XQ + 128 * hm + d4 + e]); ss += x[e] * x[e]; }
        ss += __shfl_xor(ss, 1); ss += __shfl_xor(ss, 2); ss += __shfl_xor(ss, 4); ss += __shfl_xor(ss, 8); ss += __shfl_xor(ss, 16);
        const float rstd = 0.08838834764831845f / sqrtf(ss * (1.f / 128.f) + 1e-5f);
#pragma unroll
        for (int e = 0; e < 4; ++e) q4[e] = x[e] * rstd * F.in[I_XQN][d4 + e]; }
    const float* kb = F.in[I_CMK] + ((size_t)bs * 256 * 4 + hm) * 128 + d4; const float* vb = F.in[I_CMV] + ((size_t)bs * 256 * 4 + hm) * 128 + d4;
#pragma unroll 1
    for (int i = 0; i < 128; i += 4) {
        float part[4];
#pragma unroll
        for (int u = 0; u < 4; ++u) { const f32x4 k4 = *(const f32x4*)(kb + (size_t)(2 * (i + u) + half) * 512); part[u] = k4[0] * q4[0] + k4[1] * q4[1] + k4[2] * q4[2] + k4[3] * q4[3]; }
#pragma unroll
        for (int u = 0; u < 4; ++u) { float p = part[u]; p += __shfl_xor(p, 1); p += __shfl_xor(p, 2); p += __shfl_xor(p, 4); p += __shfl_xor(p, 8); p += __shfl_xor(p, 16);
            if ((lane & 31) == 0) sc[2 * (i + u) + half] = p; }
    }
    float s4[4]; float mx = -INFINITY;
#pragma unroll
    for (int e = 0; e < 4; ++e) { s4[e] = sc[lane + 64 * e]; mx = fmaxf(mx, s4[e]); }
    mx = wave_max(mx); float l = 0.f;
#pragma unroll
    for (int e = 0; e < 4; ++e) { s4[e] = __expf(s4[e] - mx); l += s4[e]; }
    l = wave_sum(l);
#pragma unroll
    for (int e = 0; e < 4; ++e) sc[lane + 64 * e] = s4[e];
    f32x4 o = (f32x4){0.f, 0.f, 0.f, 0.f};
#pragma unroll 1
    for (int i = 0; i < 128; i += 4) {
#pragma unroll
        for (int u = 0; u < 4; ++u) { const int key = 2 * (i + u) + half; const f32x4 v4 = *(const f32x4*)(vb + (size_t)key * 512); o += v4 * sc[key]; }
    }
#pragma unroll
    for (int e = 0; e < 4; ++e) o[e] += __shfl_xor(o[e], 32);
    if (half == 0) { const float il = 1.f / l; typedef unsigned u32x2 __attribute__((ext_vector_type(2)));
        u32x2 w; w.x = pk2(o[0] * il, o[1] * il); w.y = pk2(o[2] * il, o[3] * il);
        *(u32x2*)((bf16*)(F.ws + WS_OC) + m * 512 + 128 * hm + d4) = w; }
}

template <bool SAMPLE>
__device__ __forceinline__ void rwkv_task(Frame& F, LAS float* wl, int h, int m0, int ngrp, float* s_out) {
    const int lane0 = lane_id_asm(); const int ch = 64 * h + lane0;
    const bf16* proj = (const bf16*)(F.ws + WS_PROJ);
    const bf16* w2t = (const bf16*)(F.ws + WS_W2T); const bf16* a2t = (const bf16*)(F.ws + WS_A2T); const bf16* g2t = (const bf16*)(F.ws + WS_G2T);
    const float* mu = F.in[I_MU];
    LAS float* dec = wl; LAS float* aa = wl + 1024; LAS bf16* gg = (LAS bf16*)(wl + 2048); LAS float* vec = wl + 2560; LAS float* ybuf = wl + 4096; LAS float* bonl = wl + 4352;
    const float mu_r = mu[ch], mu_k = mu[512 + ch], mu_v = mu[1024 + ch], kk_c = F.in[I_KK][ch], ka_c = F.in[I_KA][ch], rk_c = F.in[I_RK][ch], lnw = F.in[I_LNW][ch], lnb = F.in[I_LNB][ch];
    float S[4][16];
#pragma unroll
    for (int i = 0; i < 4; ++i)
#pragma unroll
        for (int j = 0; j < 16; ++j) S[i][j] = 0.f;
    bf16* oa = (bf16*)(F.ws + WS_OA);
#pragma unroll 1
    for (int grp = 0; grp < ngrp; ++grp) {
        {   int ln = lane0; asm volatile("" : "+v"(ln)); const int c16 = ln & 15, gq = ln >> 4;
            const int m = m0 + 16 * grp + c16; const bool first = (!SAMPLE) && (grp == 0) && (c16 == 0);
            bf16x8 af[8]; const float* mup = mu; asm volatile("" : "+s"(mup));
#pragma unroll
            for (int f = 0; f < 8; ++f) {
                const int col = 1536 + 32 * f + 8 * gq;
                float z[8], zp[8]; unpack8(*(const v4u*)(proj + (size_t)m * PC + col), z);
                if (SAMPLE) { const float* sp = F.in[I_SHIFT] + (size_t)(m - MPROMPT) * ZC + col; const f32x4 a = *(const f32x4*)sp, b = *(const f32x4*)(sp + 4);
                    zp[0] = a[0]; zp[1] = a[1]; zp[2] = a[2]; zp[3] = a[3]; zp[4] = b[0]; zp[5] = b[1]; zp[6] = b[2]; zp[7] = b[3]; }
                else { unpack8(*(const v4u*)(proj + (size_t)(first ? m : m - 1) * PC + col), zp);
                    if (first) {
#pragma unroll
                        for (int j = 0; j < 8; ++j) zp[j] = 0.f; } }
                const f32x4 m0v = *(const f32x4*)(mup + col), m1v = *(const f32x4*)(mup + col + 4);
#pragma unroll
                for (int j = 0; j < 8; ++j) { const float mj = j < 4 ? m0v[j] : m1v[j - 4]; float v = z[j] + (zp[j] - z[j]) * mj;
                    if (f < 2) { const float e2 = __expf(2.f * v); v = 1.f - 2.f / (e2 + 1.f); } else if (f >= 4) v = 1.f / (1.f + __expf(-v)); z[j] = v; }
                af[f] = as_frag(pack8(z));
                __builtin_amdgcn_sched_barrier(0);
            }
#pragma unroll 1
            for (int nt = 0; nt < 4; ++nt) { const int n = 64 * h + 16 * nt + c16;
                const bf16* wp = w2t + n * 64 + 8 * gq; const bf16* ap = a2t + n * 64 + 8 * gq; const bf16* gp = g2t + n * 128 + 8 * gq;
                f32x4 accw = (f32x4){0.f, 0.f, 0.f, 0.f}, acca = accw, accg = accw;
                accw = MFMA16(af[0], *(const bf16x8*)wp, accw); accw = MFMA16(af[1], *(const bf16x8*)(wp + 32), accw);
                acca = MFMA16(af[2], *(const bf16x8*)ap, acca); acca = MFMA16(af[3], *(const bf16x8*)(ap + 32), acca);
#pragma unroll
                for (int f = 0; f < 4; ++f) accg = MFMA16(af[4 + f], *(const bf16x8*)(gp + 32 * f), accg);
                const float w0v = F.in[I_W0][n], a0v = F.in[I_A0][n];
#pragma unroll
                for (int r = 0; r < 4; ++r) { const int tl = 4 * gq + r, cc = 16 * nt + c16;
                    const float x = -(w0v + accw[r]);
                    const float sp = fmaxf(x, 0.f) + log1pf(expf(-fabsf(x)));
                    dec[tl * 64 + cc] = expf(-expf(-sp - 0.5f));
                    aa[tl * 64 + cc] = 1.f / (1.f + expf(-(a0v + acca[r])));
                    gg[tl * 64 + cc] = (bf16)f2bf(accg[r]); }
            }
        }
#pragma unroll 1
        for (int sub = 0; sub < 4; ++sub) {
            int lane = lane0; asm volatile("" : "+v"(lane)); const int vb = lane >> 2, kb = lane & 3;
#pragma unroll 1
            for (int tt = 0; tt < 4; ++tt) {
                const int tl = 4 * sub + tt, m = m0 + 16 * grp + tl; const bf16* zr = proj + (size_t)m * PC + ch;
                const float z_r = bf2f(zr[0]), z_k = bf2f(zr[512]), z_v = bf2f(zr[1024]); float p_r, p_k, p_v;
                if (SAMPLE) { const float* sp = F.in[I_SHIFT] + (size_t)(m - MPROMPT) * ZC + ch; p_r = sp[0]; p_k = sp[512]; p_v = sp[1024]; }
                else if (grp == 0 && tl == 0) { p_r = 0.f; p_k = 0.f; p_v = 0.f; }
                else { p_r = bf2f(zr[-PC]); p_k = bf2f(zr[512 - PC]); p_v = bf2f(zr[1024 - PC]); }
                const float r = z_r + (p_r - z_r) * mu_r, k = z_k + (p_k - z_k) * mu_k, v = z_v + (p_v - z_v) * mu_v;
                const float a = aa[tl * 64 + lane], d = dec[tl * 64 + lane];
                const float kk0 = k * kk_c; const float nrm = sqrtf(wave_sum(kk0 * kk0)); const float kk = kk0 / fmaxf(nrm, 1e-12f);
                const float kh = k * (1.f + (a - 1.f) * ka_c);
                const float bon = wave_sum(r * kh * rk_c);
                LAS float* vp = vec + tt * 384;
                vp[lane] = d; vp[64 + lane] = kk; vp[128 + lane] = kk * a; vp[192 + lane] = kh; vp[256 + lane] = r; vp[320 + lane] = v;
                if (lane == 0) bonl[tt] = bon;
            }
#pragma unroll 1
            for (int tt = 0; tt < 4; ++tt) {
                const int tl = 4 * sub + tt, m = m0 + 16 * grp + tl;
                if (SAMPLE) { const float* sp = F.in[I_SRW] + (((size_t)(m - MPROMPT) * 8 + h) * 64 + 4 * vb) * 64 + 16 * kb;
#pragma unroll
                    for (int i = 0; i < 4; ++i)
#pragma unroll
                        for (int q4 = 0; q4 < 4; ++q4) { const f32x4 t = *(const f32x4*)(sp + i * 64 + 4 * q4); S[i][4 * q4] = t[0]; S[i][4 * q4 + 1] = t[1]; S[i][4 * q4 + 2] = t[2]; S[i][4 * q4 + 3] = t[3]; } }
                const LAS float* vp = vec + tt * 384 + 16 * kb;
                float w[16], kkv[16], bv[16], kv[16], rv[16];
#pragma unroll
                for (int q4 = 0; q4 < 4; ++q4) { const f32x4 t0 = *(const LAS f32x4*)(vp + 4 * q4), t1 = *(const LAS f32x4*)(vp + 64 + 4 * q4), t2 = *(const LAS f32x4*)(vp + 128 + 4 * q4),
                        t3 = *(const LAS f32x4*)(vp + 192 + 4 * q4), t4 = *(const LAS f32x4*)(vp + 256 + 4 * q4);
#pragma unroll
                    for (int e = 0; e < 4; ++e) { w[4 * q4 + e] = t0[e]; kkv[4 * q4 + e] = t1[e]; bv[4 * q4 + e] = t2[e]; kv[4 * q4 + e] = t3[e]; rv[4 * q4 + e] = t4[e]; } }
                const f32x4 v4 = *(const LAS f32x4*)(vec + tt * 384 + 320 + 4 * vb);
                f32x4 yv;
#pragma unroll
                for (int i = 0; i < 4; ++i) { float a0 = 0.f, a1 = 0.f;
#pragma unroll
                    for (int j = 0; j < 16; j += 2) { a0 += S[i][j] * kkv[j]; a1 += S[i][j + 1] * kkv[j + 1]; }
                    float a = a0 + a1; a += dpp_xor1(a); a += dpp_xor2(a); const float sa = -a; const float vi = v4[i];
                    float y0 = 0.f, y1 = 0.f;
#pragma unroll
                    for (int j = 0; j < 16; j += 2) { S[i][j] = S[i][j] * w[j] + sa * bv[j] + vi * kv[j]; S[i][j + 1] = S[i][j + 1] * w[j + 1] + sa * bv[j + 1] + vi * kv[j + 1];
                        y0 += S[i][j] * rv[j]; y1 += S[i][j + 1] * rv[j + 1]; }
                    float y = y0 + y1; y += dpp_xor1(y); y += dpp_xor2(y); yv[i] = y; }
                if (kb == 0) *(LAS f32x4*)(ybuf + tt * 64 + 4 * vb) = yv;
                if (SAMPLE) { float* sp = F.out + O_SS + (((size_t)(m - MPROMPT) * 8 + h) * 64 + 4 * vb) * 64 + 16 * kb;
#pragma unroll
                    for (int i = 0; i < 4; ++i)
#pragma unroll
                        for (int q4 = 0; q4 < 4; ++q4) *(f32x4*)(sp + i * 64 + 4 * q4) = (f32x4){S[i][4 * q4], S[i][4 * q4 + 1], S[i][4 * q4 + 2], S[i][4 * q4 + 3]}; }
            }
#pragma unroll 1
            for (int tt = 0; tt < 4; ++tt) {
                const int tl = 4 * sub + tt, m = m0 + 16 * grp + tl;
                const float y = ybuf[tt * 64 + lane]; const float mean = wave_sum(y) * (1.f / 64.f); const float dd = y - mean;
                const float var = wave_sum(dd * dd) * (1.f / 64.f);
                const float yn = dd / sqrtf(var + 64e-5f) * lnw + lnb;
                const float o = (yn + bonl[tt] * vec[tt * 384 + 320 + lane]) * bf2f(gg[tl * 64 + lane]);
                oa[(size_t)m * 512 + ch] = (bf16)f2bf(o);
            }
        }
    }
    if (!SAMPLE) { const int vb = lane0 >> 2, kb = lane0 & 3; float* sp = s_out + (size_t)(4 * vb) * 64 + 16 * kb;
#pragma unroll
        for (int i = 0; i < 4; ++i)
#pragma unroll
            for (int q4 = 0; q4 < 4; ++q4) *(f32x4*)(sp + i * 64 + 4 * q4) = (f32x4){S[i][4 * q4], S[i][4 * q4 + 1], S[i][4 * q4 + 2], S[i][4 * q4 + 3]}; }
}

__global__ void __launch_bounds__(NWAVES * 64, 2) fwd_kernel(Params p) {
    extern __shared__ __attribute__((aligned(16))) unsigned char lds_raw[];
    Frame F;
    F.lds = (LAS unsigned char*)lds_raw; F.wave = __builtin_amdgcn_readfirstlane((int)threadIdx.x >> 6);
    F.G = gridDim.x; F.bid = blockIdx.x; F.in = p.in; F.out = p.out; F.ws = p.ws;
    volatile LAS unsigned* MISC = (volatile LAS unsigned*)(F.lds + MISC_OFF);
    if ((F.wave * 64 + lane_id_asm()) < 128) MISC[(F.wave * 64 + lane_id_asm())] = 0u;
    __syncthreads();
    XcdBarrier bar = xcd_barrier_post((unsigned*)(p.ws + WS_CTL) + CW_BAR, MISC + 8, F.wave);
    if (p.never) cg::this_grid().sync();
    unsigned char* ws = p.ws;
    LAS float* wl = (LAS float*)(F.lds + F.wave * WSZ);

    p0_prologue(F);
    xcd_barrier(bar, F.wave);

#ifndef NO_P1
    {   pg8::Gemm g{(const pg8::bf16_t*)(ws + WS_XN), (const pg8::bf16_t*)(ws + WS_WIN), MP, PC, 1024};
        P1Order S; S.so.init(MP, PC, F.G, (int)blockIdx.x);
        EpiP1 E{(pg8::bf16_t*)(ws + WS_PROJ), (pg8::bf16_t*)(ws + WS_KVB)};
        pg8::gemm_phase<EpiP1, P1Order, true, true>(F.lds, g, S, E, F.wave);
    }
    xcd_barrier(bar, F.wave);

#endif
#ifndef NO_SWA
    for (int u = F.bid; u < 256; u += F.G) { const int rem = u & 127; swa_unit(F, u >> 7, rem & 1, rem >> 1); }
#endif
#ifndef NO_MEM
    for (int u = F.bid; u < 256; u += F.G) { const int rem = u & 127; mem_unit(F, u >> 7, rem & 3, rem >> 2); }
#endif
#ifndef NO_WT
    for (int t = F.bid * NWAVES + F.wave; t < 850; t += F.G * NWAVES) {
#ifndef NO_RW
        if (t < 16) rwkv_task<false>(F, wl, t & 7, (t >> 3) * TSEQ, TSEQ / 16, F.out + O_SP + (size_t)t * 4096);
        else if (t < 80) { const int i = t - 16; rwkv_task<true>(F, wl, i & 7, MPROMPT + 16 * (i >> 3), 1, nullptr); }
        else
#endif
#ifndef NO_SS
        if (t < 208) swa_sample_task(F, wl, t - 80);
        else
#endif
#ifndef NO_MS
        if (t < 720) { const int i = t - 208; mem_sample_task(F, wl, i >> 2, i & 3); }
        else
#endif
        {
        const int rr = t - 720; const size_t m = rr < 2 ? (size_t)rr * TSEQ + TSEQ - 1 : (size_t)MPROMPT + (rr - 2);
            float* o = rr < 2 ? F.out + O_ZP + (size_t)rr * ZC : F.out + O_ZS + (size_t)(rr - 2) * ZC; const bf16* zr = (const bf16*)(ws + WS_PROJ) + m * PC;
            int l0 = lane_id_asm(); asm volatile("" : "+v"(l0));
#pragma unroll 1
            for (int c = l0; c < ZC; c += 64) o[c] = bf2f(zr[c]); }
    }
#endif
    xcd_barrier(bar, F.wave);
#ifndef NO_P5
    {
        pg8::StaticOrder S; S.init(MP, 1024, F.G, (int)blockIdx.x);
        pg8::bf16_t* gate = (pg8::bf16_t*)(ws + WS_GATE); float* macc = (float*)(ws + WS_MACC); pg8::bf16_t* mrg = (pg8::bf16_t*)(ws + WS_MRG);
        const pg8::bf16_t* xn = (const pg8::bf16_t*)(ws + WS_XN); const pg8::bf16_t* win = (const pg8::bf16_t*)(ws + WS_WIN);
        EpiGate EG{gate};
        { pg8::Gemm g{xn, win + (size_t)3072 * 1024, MP, 1024, 1024}; pg8::gemm_phase<EpiGate, pg8::StaticOrder, true, true>(F.lds, g, S, EG, F.wave); }
        { pg8::Gemm g{(const pg8::bf16_t*)(ws + WS_OA), (const pg8::bf16_t*)(ws + WS_WBA), MP, 1024, 512}; EpiBr<0> E{gate, macc, mrg}; pg8::gemm_phase<EpiBr<0>, pg8::StaticOrder, true, true>(F.lds, g, S, E, F.wave); }
        { pg8::Gemm g{xn, win + (size_t)4096 * 1024, MP, 1024, 1024}; pg8::gemm_phase<EpiGate, pg8::StaticOrder, true, true>(F.lds, g, S, EG, F.wave); }
        { pg8::Gemm g{(const pg8::bf16_t*)(ws + WS_OB), (const pg8::bf16_t*)(ws + WS_WBB), MP, 1024, 512}; EpiBr<1> E{gate, macc, mrg}; pg8::gemm_phase<EpiBr<1>, pg8::StaticOrder, true, true>(F.lds, g, S, E, F.wave); }
        { pg8::Gemm g{xn, win + (size_t)5120 * 1024, MP, 1024, 1024}; pg8::gemm_phase<EpiGate, pg8::StaticOrder, true, true>(F.lds, g, S, EG, F.wave); }
        { pg8::Gemm g{(const pg8::bf16_t*)(ws + WS_OC), (const pg8::bf16_t*)(ws + WS_WBC), MP, 1024, 512}; EpiBr<2> E{gate, macc, mrg}; pg8::gemm_phase<EpiBr<2>, pg8::StaticOrder, true, true>(F.lds, g, S, E, F.wave); }
    }
    xcd_barrier(bar, F.wave);
#endif
#ifndef NO_P6
    {   pg8::StaticOrder S; S.init(MP, 1024, F.G, (int)blockIdx.x);
        pg8::Gemm g{(const pg8::bf16_t*)(ws + WS_MRG), (const pg8::bf16_t*)(ws + WS_WOUT), MP, 1024, 1024};
        EpiOut E{F.in[I_XP], F.in[I_XS], F.out, (pg8::bf16_t*)(ws + WS_XN), (float*)(ws + WS_SQ)};
        pg8::gemm_phase<EpiOut, pg8::StaticOrder, true, true>(F.lds, g, S, E, F.wave);
    }
    xcd_barrier(bar, F.wave);
#endif
#ifndef NO_P7
    {   pg8::StaticOrder S; S.init(MP, 4096, F.G, (int)blockIdx.x);
        pg8::Gemm g{(const pg8::bf16_t*)(ws + WS_XN), (const pg8::bf16_t*)(ws + WS_WUP), MP, 4096, 1024};
        EpiUp E{(const float*)(ws + WS_SQ), (pg8::bf16_t*)(ws + WS_H)};
        pg8::gemm_phase<EpiUp, pg8::StaticOrder, true, true>(F.lds, g, S, E, F.wave);
    }
    xcd_barrier(bar, F.wave);
#endif
#ifndef NO_P8
    {   pg8::StaticOrder S; S.init(MP, 1024, F.G, (int)blockIdx.x);
        pg8::Gemm g{(const pg8::bf16_t*)(ws + WS_H), (const pg8::bf16_t*)(ws + WS_WDN), MP, 1024, 4096};
        EpiDown E{F.out};
        pg8::gemm_phase<EpiDown, pg8::StaticOrder, true, true>(F.lds, g, S, E, F.wave);
    }
#endif
}

extern "C" void kernel_launch(void* const* d_in, const int* in_sizes, int n_in, void* d_out, int out_size, void* d_ws, size_t ws_size, hipStream_t stream) {
    static int grid = 0;
    if (grid == 0) {
        if (n_in != 36 || ws_size < WS_END) { fprintf(stderr, "kernel_launch: unexpected n_in %d / ws %zu\n", n_in, ws_size); grid = -1; return; }
        int dev = 0, cus = 0, per_cu = 0;
        if (hipGetDevice(&dev) != hipSuccess || hipDeviceGetAttribute(&cus, hipDeviceAttributeMultiprocessorCount, dev) != hipSuccess) { grid = -1; return; }
        if (hipFuncSetAttribute((const void*)fwd_kernel, hipFuncAttributeMaxDynamicSharedMemorySize, LDS_BYTES) != hipSuccess) { fprintf(stderr, "kernel_launch: hipFuncSetAttribute failed\n"); grid = -1; return; }
        if (hipOccupancyMaxActiveBlocksPerMultiprocessor(&per_cu, (const void*)fwd_kernel, NWAVES * 64, LDS_BYTES) != hipSuccess || per_cu < 1) { fprintf(stderr, "kernel_launch: occupancy query says %d\n", per_cu); per_cu = 1; }
        (void)hipGetLastError();
        grid = cus;
    }
    if (grid < 0) return;
    if (hipMemsetAsync((char*)d_ws + WS_CTL, 0, CTL_ZERO_BYTES, stream) != hipSuccess) { fprintf(stderr, "kernel_launch: memset failed\n"); return; }
    Params a{};
    for (int i = 0; i < 36; ++i) a.in[i] = (const float*)d_in[i];
    a.out = (float*)d_out; a.ws = (unsigned char*)d_ws; a.never = 0; a.pad = 0;
    void* args[] = {&a};
    hipError_t e = hipLaunchCooperativeKernel((const void*)fwd_kernel, dim3(grid), dim3(NWAVES * 64), args, LDS_BYTES, stream);
    if (e != hipSuccess) fprintf(stderr, "kernel_launch: cooperative launch failed: %s (grid %d)\n", hipGetErrorString(e), grid);
}
```

```cpp
#include <hip/hip_runtime.h>
#include <hip/hip_cooperative_groups.h>
#include <cstdio>
#include <cstdint>
namespace cg = cooperative_groups;
#ifndef REPEAT_PHASE
#define REPEAT_PHASE 0
#endif
__device__ __forceinline__ int lane_id_asm() { int l; asm volatile("v_mbcnt_lo_u32_b32 %0, -1, 0\n\tv_mbcnt_hi_u32_b32 %0, -1, %0" : "=v"(l)); return l; }
namespace pg8 {
#define PG8_LAS __attribute__((address_space(3)))
typedef unsigned short bf16_t;
typedef short bf16x8 __attribute__((ext_vector_type(8)));
typedef float f32x4 __attribute__((ext_vector_type(4)));
typedef unsigned u32x4 __attribute__((ext_vector_type(4)));
constexpr int BM = 256, BK = 64, HALF = 128, HTB = HALF * BK * 2  , STAGE_BYTES = 8 * HTB, NXCD = 8, WGM = 8;

__host__ __device__ __forceinline__ int lds_byte(int r, int c) { const int st = (r >> 4) * 2 + (c >> 5), rr = r & 15, cc = c & 31, ob = rr * 64 + cc * 2; return st * 1024 + (ob ^ (((ob >> 9) & 1) << 5)); }
__host__ __device__ __forceinline__ void stage_rc(int b, int& R, int& C) { const int st = b / 1024, sb = b % 1024, swz = sb ^ (((sb >> 9) & 1) << 5); R = (st >> 1) * 16 + swz / 64; C = (st & 1) * 32 + (swz % 64) / 2; }
__host__ __device__ __forceinline__ int perm32(int rho) { const int n = rho >> 4, i = rho & 15; return 8 * (i >> 2) + 4 * n + (i & 3); }

struct Unit { int pm, pn; };
struct Gemm { const bf16_t* A; const bf16_t* Bt; int M, N, K; };

struct StaticOrder {
    int nM, nN, nwg, G, c;
    __host__ __device__ void init(int M, int N, int G_, int c_) { nM = M / BM; nN = N / BM; nwg = nM * nN; G = G_; c = c_; }
    __host__ __device__ bool next(int i, Unit& u) const {
        const long L = (long)i * G + c; if (L >= nwg) return false;
        int wgid = (int)L; { const int q = nwg / NXCD, r = nwg % NXCD, xcd = wgid % NXCD, off = wgid / NXCD; wgid = (xcd < r ? xcd * (q + 1) : r * (q + 1) + (xcd - r) * q) + off; }
        const int nig = WGM * nN, gid = wgid / nig, fm = gid * WGM, gsz = (nM - fm) < WGM ? (nM - fm) : WGM;
        u.pm = fm + ((wgid % nig) % gsz); u.pn = (wgid % nig) / gsz; return true;
    }
    __device__ __forceinline__ void a_ready(const Unit&) const {}
    __device__ __forceinline__ void done(const Unit&) const {}
};

__device__ __forceinline__ unsigned cvt_pk_bf16(float lo, float hi) { unsigned r; asm volatile("v_cvt_pk_bf16_f32 %0, %1, %2" : "=v"(r) : "v"(lo), "v"(hi)); return r; }
typedef float f32x2 __attribute__((ext_vector_type(2)));
template <class Epi, class Sched, bool ALIGN_EPI = false, bool SP2 = false>
__device__ __forceinline__ void gemm_phase(PG8_LAS unsigned char* lds, const Gemm g, const Sched& S, const Epi& E, int wave_id) {
    const int tid_l = wave_id * 64 + lane_id_asm();
    const int tid = tid_l, wid = __builtin_amdgcn_readfirstlane(tid >> 6), lane = tid & 63, wr = wid >> 2, wc = wid & 3, fr = lane & 15, fq = lane >> 4;
    const int K = g.K, nt = K / BK;
    unsigned voffA[2], voffB[2];
#pragma unroll
    for (int i = 0; i < 2; ++i) { int R, C; stage_rc(tid * 16 + i * 8192, R, C); const int Rb = Epi::PERM ? ((R & ~31) + perm32(R & 31)) : R;
        voffA[i] = (unsigned)(R * K + C) * 2u; voffB[i] = (unsigned)(Rb * K + C) * 2u; }
    const size_t kstep = (size_t)(BK * 2);
    const size_t hstep = (size_t)HALF * K * 2;
    const size_t tstep = 2 * hstep;
    const unsigned ldsw = (unsigned)wid * 1024u;
    const int aoff = lds_byte(wr * 64 + fr, fq * 8), boff = lds_byte(wc * 32 + fr, fq * 8);
#define PG8_SA(b, h) (((b) * 2 + (h)) * HTB)
#define PG8_SB(b, h) ((4 + (b) * 2 + (h)) * HTB)
#define PG8_STAGE(bufoff, gbase, voff) do { _Pragma("unroll") for (int _i = 0; _i < 2; ++_i) \
        __builtin_amdgcn_global_load_lds((const unsigned*)((const char*)(gbase) + (voff)[_i]), (PG8_LAS unsigned*)(lds + (bufoff) + ldsw + _i * 8192), 16, 0, 0); } while (0)
#define PG8_LDA(dst, b, h) do { _Pragma("unroll") for (int m = 0; m < 4; ++m) _Pragma("unroll") for (int k = 0; k < 2; ++k) dst[m][k] = *(const PG8_LAS bf16x8*)(lds + PG8_SA(b, h) + aoff + m * 2048 + k * 1024); } while (0)
#define PG8_LDB(dst, b, h) do { _Pragma("unroll") for (int n = 0; n < 2; ++n) _Pragma("unroll") for (int k = 0; k < 2; ++k) dst[n][k] = *(const PG8_LAS bf16x8*)(lds + PG8_SB(b, h) + boff + n * 2048 + k * 1024); } while (0)
#define PG8_MMA(ai, bj, At, Bt) do { __builtin_amdgcn_s_setprio(1); _Pragma("unroll") for (int m = 0; m < 4; ++m) _Pragma("unroll") for (int n = 0; n < 2; ++n) _Pragma("unroll") for (int k = 0; k < 2; ++k) \
        acc[ai][bj][m][n] = __builtin_amdgcn_mfma_f32_16x16x32_bf16(Bt[n][k], At[m][k], acc[ai][bj][m][n], 0, 0, 0); __builtin_amdgcn_s_setprio(0); } while (0)
#define PG8_WAIT_V(n) asm volatile("s_waitcnt vmcnt(" #n ")" ::: "memory")
#define PG8_WAIT_L(n) asm volatile("s_waitcnt lgkmcnt(" #n ")" ::: "memory")
#define PG8_BAR __builtin_amdgcn_s_barrier()
#define PG8_SCHED __builtin_amdgcn_sched_barrier(0)
    Unit cur, nxt; int ui = 0;
    if (!S.next(0, cur)) return;
    f32x4 acc[2][2][4][2];
#pragma unroll
    for (int a = 0; a < 2; ++a)
#pragma unroll
        for (int b = 0; b < 2; ++b)
#pragma unroll
            for (int m = 0; m < 4; ++m)
#pragma unroll
                for (int n = 0; n < 2; ++n) acc[a][b][m][n] = (f32x4){0.f, 0.f, 0.f, 0.f};
    bf16x8 At[4][2], B0[2][2], B1[2][2];
    const char* cA = (const char*)g.A + (size_t)cur.pm * tstep; const char* cB = (const char*)g.Bt + (size_t)cur.pn * tstep;
    S.a_ready(cur);
    if constexpr (SP2) {
        PG8_STAGE(PG8_SB(0, 0), cB, voffB); PG8_STAGE(PG8_SB(0, 1), cB + hstep, voffB); PG8_STAGE(PG8_SA(0, 0), cA, voffA); PG8_STAGE(PG8_SA(0, 1), cA + hstep, voffA);
        if (wr == 1) PG8_BAR;
        PG8_WAIT_V(2); PG8_BAR;
        PG8_STAGE(PG8_SB(1, 0), cB + kstep, voffB); PG8_STAGE(PG8_SA(1, 0), cA + kstep, voffA); PG8_STAGE(PG8_SB(1, 1), cB + hstep + kstep, voffB);
        PG8_WAIT_V(6); PG8_BAR;
    } else {
        PG8_STAGE(PG8_SB(0, 0), cB, voffB); PG8_STAGE(PG8_SA(0, 0), cA, voffA); PG8_STAGE(PG8_SB(0, 1), cB + hstep, voffB); PG8_STAGE(PG8_SA(0, 1), cA + hstep, voffA);
        if (wr == 1) PG8_BAR;
        PG8_WAIT_V(4); PG8_BAR;
        PG8_STAGE(PG8_SB(1, 0), cB + kstep, voffB); PG8_STAGE(PG8_SA(1, 0), cA + kstep, voffA); PG8_STAGE(PG8_SB(1, 1), cB + hstep + kstep, voffB);
        PG8_WAIT_V(6); PG8_BAR;
    }
    for (;;) {
        const bool has_next = S.next(ui + 1, nxt);
        const char* nA = has_next ? (const char*)g.A + (size_t)nxt.pm * tstep : cA; const char* nB = has_next ? (const char*)g.Bt + (size_t)nxt.pn * tstep : cB;
        for (int t = 0; t < nt; t += 2) {
            const bool last = (t == nt - 2);
            const char* a1 = cA + (size_t)(t + 1) * kstep;
            const char* a2 = last ? nA : cA + (size_t)(t + 2) * kstep; const char* b2 = last ? nB : cB + (size_t)(t + 2) * kstep;
            const char* a3 = a2 + kstep; const char* b3 = b2 + kstep;
            if (last && has_next) S.a_ready(nxt);
            if constexpr (SP2) {
            PG8_LDB(B0, 0, 0); PG8_LDB(B1, 0, 1); PG8_SCHED; PG8_LDA(At, 0, 0); PG8_STAGE(PG8_SA(1, 1), a1 + hstep, voffA);
            PG8_WAIT_V(8); PG8_WAIT_L(0); PG8_BAR; PG8_MMA(0, 0, At, B0); PG8_MMA(0, 1, At, B1); PG8_BAR; PG8_SCHED;
            PG8_LDA(At, 0, 1); PG8_STAGE(PG8_SB(0, 0), b2, voffB); PG8_STAGE(PG8_SB(0, 1), b2 + hstep, voffB); PG8_STAGE(PG8_SA(0, 0), a2, voffA);
            PG8_WAIT_V(8); PG8_WAIT_L(0); PG8_BAR; PG8_MMA(1, 0, At, B0); PG8_MMA(1, 1, At, B1); PG8_BAR; PG8_SCHED;
            PG8_LDB(B0, 1, 0); PG8_LDB(B1, 1, 1); PG8_SCHED; PG8_LDA(At, 1, 0); PG8_STAGE(PG8_SA(0, 1), a2 + hstep, voffA);
            PG8_WAIT_V(8); PG8_WAIT_L(0); PG8_BAR; PG8_MMA(0, 0, At, B0); PG8_MMA(0, 1, At, B1); PG8_BAR; PG8_SCHED;
            PG8_LDA(At, 1, 1); PG8_STAGE(PG8_SB(1, 0), b3, voffB); PG8_STAGE(PG8_SB(1, 1), b3 + hstep, voffB); PG8_STAGE(PG8_SA(1, 0), a3, voffA);
            PG8_WAIT_V(8); PG8_WAIT_L(0); PG8_BAR; PG8_MMA(1, 0, At, B0); PG8_MMA(1, 1, At, B1); PG8_BAR; PG8_SCHED;
            } else {
            PG8_LDB(B0, 0, 0); PG8_SCHED; PG8_LDA(At, 0, 0); PG8_STAGE(PG8_SA(1, 1), a1 + hstep, voffA);
            PG8_WAIT_L(8); PG8_BAR; PG8_WAIT_L(0); PG8_MMA(0, 0, At, B0); PG8_BAR; PG8_SCHED;
            PG8_LDB(B1, 0, 1); PG8_STAGE(PG8_SB(0, 0), b2, voffB);
            PG8_BAR; PG8_WAIT_L(0); PG8_MMA(0, 1, At, B1); PG8_BAR;
            PG8_LDA(At, 0, 1); PG8_STAGE(PG8_SA(0, 0), a2, voffA);
            PG8_BAR; PG8_WAIT_L(0); PG8_MMA(1, 0, At, B0); PG8_BAR; PG8_SCHED;
            PG8_STAGE(PG8_SB(0, 1), b2 + hstep, voffB);
            PG8_WAIT_V(6); PG8_BAR; PG8_MMA(1, 1, At, B1); PG8_BAR;
            PG8_LDB(B0, 1, 0); PG8_SCHED; PG8_LDA(At, 1, 0); PG8_STAGE(PG8_SA(0, 1), a2 + hstep, voffA);
            PG8_WAIT_L(8); PG8_BAR; PG8_WAIT_L(0); PG8_MMA(0, 0, At, B0); PG8_BAR; PG8_SCHED;
            PG8_LDB(B1, 1, 1); PG8_STAGE(PG8_SB(1, 0), b3, voffB);
            PG8_BAR; PG8_WAIT_L(0); PG8_MMA(0, 1, At, B1); PG8_BAR;
            PG8_LDA(At, 1, 1); PG8_STAGE(PG8_SA(1, 0), a3, voffA);
            PG8_BAR; PG8_WAIT_L(0); PG8_MMA(1, 0, At, B0); PG8_BAR; PG8_SCHED;
            PG8_STAGE(PG8_SB(1, 1), b3 + hstep, voffB);
            PG8_WAIT_V(6); PG8_BAR; PG8_MMA(1, 1, At, B1); PG8_BAR;
            }
        }
        if constexpr (ALIGN_EPI) { if (wr == 0) PG8_BAR; }
        if constexpr (!Epi::AFTER_DRAIN) { E(acc, cur, wr, wc, fr, fq); S.done(cur); }
        if (!has_next) break;
#pragma unroll
        for (int a = 0; a < 2; ++a)
#pragma unroll
            for (int b = 0; b < 2; ++b)
#pragma unroll
                for (int m = 0; m < 4; ++m)
#pragma unroll
                    for (int n = 0; n < 2; ++n) acc[a][b][m][n] = (f32x4){0.f, 0.f, 0.f, 0.f};
        cur = nxt; cA = nA; cB = nB; ++ui;
        if constexpr (ALIGN_EPI) { if (wr == 1) PG8_BAR; }
    }
    PG8_WAIT_V(0);
    if constexpr (!ALIGN_EPI) { if (wr == 0) PG8_BAR; }
    PG8_BAR;
    if constexpr (Epi::AFTER_DRAIN) { E.fused(acc, cur, wr, wc, fr, fq, lds, wid, lane); S.done(cur); }
#undef PG8_SA
#undef PG8_SB
#undef PG8_STAGE
#undef PG8_LDA
#undef PG8_LDB
#undef PG8_MMA
#undef PG8_WAIT_V
#undef PG8_WAIT_L
#undef PG8_BAR
#undef PG8_SCHED
}
}
#define GAS __attribute__((address_space(1)))
#define LAS __attribute__((address_space(3)))
typedef unsigned short bf16;
typedef unsigned v4u __attribute__((ext_vector_type(4)));
typedef float f32x4 __attribute__((ext_vector_type(4)));
typedef short bf16x8 __attribute__((ext_vector_type(8)));
typedef GAS unsigned gu32;
typedef GAS unsigned long long gu64;
#define RLX_AGENT __ATOMIC_RELAXED, __HIP_MEMORY_SCOPE_AGENT
#define LDS_WAIT() asm volatile("s_waitcnt lgkmcnt(0)" ::: "memory")
#define VM_WAIT() asm volatile("s_waitcnt vmcnt(0)" ::: "memory")
__device__ __forceinline__ unsigned long long rt() { return __builtin_amdgcn_s_memrealtime(); }
__device__ __forceinline__ unsigned f2bf(float f) { unsigned u = __builtin_bit_cast(unsigned, f); return (u + 0x7fffu + ((u >> 16) & 1u)) >> 16; }
__device__ __forceinline__ unsigned pk2(float lo, float hi) { return f2bf(lo) | (f2bf(hi) << 16); }

#define XB_TMO      128
#define XB_XCNT(j)  (256  + 64 * (j))
#define XB_XSUB(j)  (1280 + 64 * (j))
#define XB_XGEN(j)  (2304 + 64 * (j))
#define XB_TOP      3328
#define XB_TOPGEN   3392
#define XCD_BAR_WORDS 3456
#define XB_SPIN_CAP (1u << 18)

__device__ __forceinline__ unsigned xb_ld(unsigned* p)              { return __hip_atomic_load(p, __ATOMIC_RELAXED, __HIP_MEMORY_SCOPE_AGENT); }
__device__ __forceinline__ unsigned xb_add(unsigned* p, unsigned v) { return __hip_atomic_fetch_add(p, v, __ATOMIC_RELAXED, __HIP_MEMORY_SCOPE_AGENT); }
__device__ __forceinline__ unsigned xb_xcc_id() { return (unsigned)__builtin_amdgcn_s_getreg((3 << 11) | 20) & 0xFu; }
#define XB_SPIN(cond, bar) do { unsigned _sp = 0; while (cond) { __builtin_amdgcn_s_sleep(1); \
    if ((++_sp & 255u) == 0u) { if (xb_ld(&(bar)[XB_TMO])) break; if (_sp > XB_SPIN_CAP) { atomicAdd(&(bar)[XB_TMO], 1u); break; } } } } while (0)

struct XcdBarrier {
    unsigned* bar; unsigned x;
    volatile LAS unsigned* st;
};

__device__ __forceinline__ XcdBarrier xcd_barrier_post(unsigned* bar, volatile LAS unsigned* st, int bwave) {
    XcdBarrier b; b.bar = bar; b.x = xb_xcc_id(); b.st = st;
    if (bwave == 0 && lane_id_asm() == 0) (void)xb_add(&bar[XB_XCNT(b.x)], 1u);
    return b;
}
__device__ __forceinline__ void xcd_barrier_complete(unsigned* bar, unsigned x, unsigned& nloc, unsigned& nx) {
    const unsigned G = gridDim.x * gridDim.y * gridDim.z;
    unsigned sum, cnt, mine, sp = 0u;
    for (;;) {
        sum = 0u; cnt = 0u; mine = 0u;
#pragma unroll
        for (unsigned j = 0; j < 16; ++j) { const unsigned c = xb_ld(&bar[XB_XCNT(j)]); sum += c; cnt += (c > 0u) ? 1u : 0u; mine = (j == x) ? c : mine; }
        if (sum == G) break;
        __builtin_amdgcn_s_sleep(1);
        if ((++sp & 255u) == 0u) { if (xb_ld(&bar[XB_TMO])) break; if (sp > XB_SPIN_CAP) { atomicAdd(&bar[XB_TMO], 1u); break; } }
    }
    nloc = mine > 0u ? mine : 1u; nx = cnt > 0u ? cnt : 1u;
}

__device__ __forceinline__ void xcd_barrier(const XcdBarrier& b, int bwave) {
    asm volatile("s_waitcnt vmcnt(0)" ::: "memory");
    __syncthreads();
    if (bwave == 0 && lane_id_asm() == 0) {
        unsigned* bar = b.bar;
        __builtin_amdgcn_s_waitcnt(0);
        unsigned nloc = b.st[0], nx = b.st[1];
        if (nloc == 0u) { xcd_barrier_complete(bar, b.x, nloc, nx); b.st[0] = nloc; b.st[1] = nx; }
        const unsigned old = xb_add(&bar[XB_XSUB(b.x)], 1u);
        const unsigned gen = old / nloc;
        if (old + 1u == (gen + 1u) * nloc) {
            __builtin_amdgcn_fence(__ATOMIC_RELEASE, "agent");
            asm volatile("s_waitcnt vmcnt(0)" ::: "memory");
            const unsigned og = xb_add(&bar[XB_TOP], 1u);
            const unsigned tg = og / nx;
            if (og + 1u == (tg + 1u) * nx) xb_add(&bar[XB_TOPGEN], 1u);
            else XB_SPIN(xb_ld(&bar[XB_TOPGEN]) == tg, bar);
            __builtin_amdgcn_fence(__ATOMIC_ACQUIRE, "agent");
            xb_add(&bar[XB_XGEN(b.x)], 1u);
            asm volatile("s_waitcnt vmcnt(0)" ::: "memory");
        } else {
            XB_SPIN(xb_ld(&bar[XB_XGEN(b.x)]) == gen, bar);
            __builtin_amdgcn_fence(__ATOMIC_ACQUIRE, "agent");
            asm volatile("s_waitcnt vmcnt(0)" ::: "memory");
        }
    }
    __syncthreads();
}

constexpr int DM = 1024, TSEQ = 8192, MPROMPT = 16384, NSAMP = 128, MTOK = 16512, MP = 16640, MA = MP + 512;
constexpr int PC = 3072;
constexpr int C_Q = 1792, C_K = 2304, C_V = 2432, C_XQ = 2560, ZC = 1792;
constexpr int NWAVES = 8;
constexpr int LDS_BYTES = 155648, MISC_OFF = LDS_BYTES - 512, WSZ = 17920;
constexpr size_t WS_CTL = 0, CTL_ZERO_BYTES = 1u << 20;
constexpr size_t WS_WIN = 1u << 20;
constexpr size_t WS_WBA = WS_WIN + (size_t)7168 * 1024 * 2;
constexpr size_t WS_WBB = WS_WBA + (size_t)1024 * 512 * 2;
constexpr size_t WS_WBC = WS_WBB + (size_t)1024 * 512 * 2;
constexpr size_t WS_WOUT = WS_WBC + (size_t)1024 * 512 * 2;
constexpr size_t WS_WUP = WS_WOUT + (size_t)1024 * 1024 * 2;
constexpr size_t WS_WDN = WS_WUP + (size_t)4096 * 1024 * 2;
constexpr size_t WS_W2T = WS_WDN + (size_t)4096 * 1024 * 2;
constexpr size_t WS_A2T = WS_W2T + 65536;
constexpr size_t WS_G2T = WS_A2T + 65536;
constexpr size_t WS_ROPE = WS_G2T + 131072;
constexpr size_t WS_SQ = WS_ROPE + (1u << 20);
constexpr size_t WS_XN = WS_SQ + (size_t)MP * 16 * 4;
constexpr size_t WS_KVB = WS_XN + (size_t)MA * 1024 * 2;
constexpr size_t WS_MRG = WS_KVB + (size_t)512 * 1024 * 2;
constexpr size_t WS_PROJ = WS_MRG + (size_t)MP * 1024 * 2;
constexpr size_t WS_OA = WS_PROJ + (size_t)MP * PC * 2;
constexpr size_t WS_OB = WS_OA + (size_t)MP * 512 * 2;
constexpr size_t WS_OC = WS_OB + (size_t)MP * 512 * 2;
constexpr size_t WS_MKN = WS_OC + (size_t)MP * 512 * 2;
constexpr size_t WS_MVT = WS_MKN + 524288;
constexpr size_t WS_END = WS_MVT + 524288;
constexpr size_t WS_GATE = WS_PROJ;
constexpr size_t WS_MACC = WS_PROJ + (size_t)MP * 1024 * 2;
constexpr size_t WS_H = WS_PROJ;
static_assert(WS_H + (size_t)MP * 4096 * 2 <= WS_MKN, "h overlay");
static_assert(WS_END <= 268435456, "d_ws map");
constexpr int CW_BAR = 4096;
constexpr size_t WS_QUEUE = 589824;
constexpr size_t WS_SQS = 524288;
constexpr size_t O_YP = 0, O_SP = 16908288, O_ZP = 16973824, O_KP = 16977408, O_VP = 17010176, O_MKP = 17042944, O_MVP = 17305088,
                 O_SS = 17567232, O_ZS = 21761536, O_KS = 21990912, O_VS = 24088064;

struct Params { const float* in[36]; float* out; unsigned char* ws; int never; int pad; };
enum { I_XP = 0, I_XS, I_SRW, I_SHIFT, I_CK, I_CV, I_CMK, I_CMV, I_MEM, I_NMIX, I_WIN, I_MU, I_W0, I_W2, I_A0, I_A2, I_G2, I_KK, I_KA, I_RK, I_LNW, I_LNB,
       I_QN, I_KN, I_SINK, I_MEMN, I_WMKV, I_XQN, I_XKN, I_WBA, I_WBB, I_WBC, I_WOUT, I_NFFN, I_WUP, I_WDN };

typedef const __attribute__((address_space(4))) unsigned long long* katab_t;
__device__ __forceinline__ katab_t ka_tab() { katab_t tab = (katab_t)__builtin_amdgcn_kernarg_segment_ptr(); asm volatile("" : "+s"(tab)); return tab; }
__device__ __forceinline__ const float* in_ptr(int i) { return (const float*)(const GAS float*)ka_tab()[i]; }
__device__ __forceinline__ float* out_ptr() { return (float*)(GAS float*)ka_tab()[36]; }
__device__ __forceinline__ unsigned char* ws_ptr() { return (unsigned char*)(GAS unsigned char*)ka_tab()[37]; }
struct Frame {
    LAS unsigned char* lds; int wave, G, bid;
};
__device__ __forceinline__ float bf2f(unsigned short u) { return __builtin_bit_cast(float, (unsigned)u << 16); }
__device__ __forceinline__ float wave_sum(float v) {
#pragma unroll
    for (int o = 1; o < 64; o <<= 1) v += __shfl_xor(v, o);
    return v;
}
__device__ __forceinline__ float wave_max(float v) {
#pragma unroll
    for (int o = 1; o < 64; o <<= 1) v = fmaxf(v, __shfl_xor(v, o));
    return v;
}
__device__ __forceinline__ float dpp_xor1(float x) { return __builtin_bit_cast(float, __builtin_amdgcn_mov_dpp(__builtin_bit_cast(int, x), 0xB1, 0xF, 0xF, true)); }
__device__ __forceinline__ float dpp_xor2(float x) { return __builtin_bit_cast(float, __builtin_amdgcn_mov_dpp(__builtin_bit_cast(int, x), 0x4E, 0xF, 0xF, true)); }
__device__ __forceinline__ void unpack8(v4u w, float* x) {
    x[0] = __builtin_bit_cast(float, w.x << 16); x[1] = __builtin_bit_cast(float, w.x & 0xffff0000u);
    x[2] = __builtin_bit_cast(float, w.y << 16); x[3] = __builtin_bit_cast(float, w.y & 0xffff0000u);
    x[4] = __builtin_bit_cast(float, w.z << 16); x[5] = __builtin_bit_cast(float, w.z & 0xffff0000u);
    x[6] = __builtin_bit_cast(float, w.w << 16); x[7] = __builtin_bit_cast(float, w.w & 0xffff0000u);
}
__device__ __forceinline__ v4u pack8(const float* y) { v4u o; o.x = pk2(y[0], y[1]); o.y = pk2(y[2], y[3]); o.z = pk2(y[4], y[5]); o.w = pk2(y[6], y[7]); return o; }
__device__ __forceinline__ bf16x8 as_frag(v4u w) { return __builtin_bit_cast(bf16x8, w); }
#define MFMA16(a, b, c) __builtin_amdgcn_mfma_f32_16x16x32_bf16((a), (b), (c), 0, 0, 0)

__device__ __forceinline__ void tr_item(const float* W, int K, int N, bf16* WT, int row_off, LAS float* scr, int item, int lane, const float* kscale) {
    const int nblk = N / 32, kb = item / nblk, nb = item % nblk, k0 = 64 * kb, n0 = 32 * nb;
#pragma unroll
    for (int i = 0; i < 32; ++i) { const int kk = 2 * i + (lane >> 5); float v = W[(size_t)(k0 + kk) * N + n0 + (lane & 31)]; if (kscale) v *= kscale[k0 + kk]; scr[kk * 33 + (lane & 31)] = v; }
    LDS_WAIT(); asm volatile("" ::: "memory");
    const int c = lane & 7;
#pragma unroll
    for (int j = 0; j < 4; ++j) { const int n = (lane >> 3) + 8 * j; const LAS float* s = scr + (8 * c) * 33 + n;
        v4u o; o.x = pk2(s[0 * 33], s[1 * 33]); o.y = pk2(s[2 * 33], s[3 * 33]); o.z = pk2(s[4 * 33], s[5 * 33]); o.w = pk2(s[6 * 33], s[7 * 33]);
        *(GAS v4u*)(WT + (size_t)(row_off + n0 + n) * K + k0 + 8 * c) = o; }
    LDS_WAIT(); asm volatile("" ::: "memory");
}
template <int CTRL> __device__ __forceinline__ float dppq1(float x) { return __builtin_bit_cast(float, __builtin_amdgcn_mov_dpp(__builtin_bit_cast(int, x), CTRL, 0xF, 0xF, true)); }
template <int CTRL, int RM> __device__ __forceinline__ float dppz1(float x) { return __builtin_bit_cast(float, __builtin_amdgcn_update_dpp(0, __builtin_bit_cast(int, x), CTRL, RM, 0xF, false)); }
__device__ __forceinline__ float wsum1(float v) { v += dppq1<0xB1>(v); v += dppq1<0x4E>(v); v += dppq1<0x141>(v); v += dppq1<0x140>(v); v += dppz1<0x142, 0xA>(v); v += dppz1<0x143, 0xC>(v);
    return __builtin_bit_cast(float, __builtin_amdgcn_readlane(__builtin_bit_cast(int, v), 63)); }
__device__ __forceinline__ void rms_rows2_to_bf16(int lane, const float* xrow0, const float* xrow1, const float* gain0, const float* gain1, bf16* orow0, bf16* orow1) {
    const GAS f32x4* xr0 = (const GAS f32x4*)xrow0 + lane; const GAS f32x4* xr1 = (const GAS f32x4*)xrow1 + lane;
    f32x4 v0[4], v1[4]; float s0 = 0.f, s1 = 0.f;
#pragma unroll
    for (int j = 0; j < 4; ++j) { v0[j] = xr0[64 * j]; v1[j] = xr1[64 * j]; }
#pragma unroll
    for (int j = 0; j < 4; ++j) { s0 += (v0[j].x * v0[j].x + v0[j].y * v0[j].y) + (v0[j].z * v0[j].z + v0[j].w * v0[j].w); s1 += (v1[j].x * v1[j].x + v1[j].y * v1[j].y) + (v1[j].z * v1[j].z + v1[j].w * v1[j].w); }
    const float r0 = 1.f / sqrtf(wsum1(s0) * (1.f / 1024.f) + 1e-5f), r1 = 1.f / sqrtf(wsum1(s1) * (1.f / 1024.f) + 1e-5f);
    const GAS f32x4* g0 = (const GAS f32x4*)gain0 + lane; const GAS f32x4* g1 = (const GAS f32x4*)gain1 + lane;
    GAS unsigned long long* o0 = (GAS unsigned long long*)orow0 + lane; GAS unsigned long long* o1 = (GAS unsigned long long*)orow1 + lane;
#pragma unroll
    for (int j = 0; j < 4; ++j) { const f32x4 ga = g0[64 * j], gb = g1[64 * j];
        o0[64 * j] = (unsigned long long)pk2(v0[j].x * r0 * ga.x, v0[j].y * r0 * ga.y) | ((unsigned long long)pk2(v0[j].z * r0 * ga.z, v0[j].w * r0 * ga.w) << 32);
        o1[64 * j] = (unsigned long long)pk2(v1[j].x * r1 * gb.x, v1[j].y * r1 * gb.y) | ((unsigned long long)pk2(v1[j].z * r1 * gb.z, v1[j].w * r1 * gb.w) << 32); }
}
__constant__ double ROPE_INVF[8] = {1.0, 0.19392274474868576, 0.03760603093086393, 0.007292664737217109, 0.001414213562373095, 0.0002742481756762073, 5.318295896944988e-05, 1.031338537721246e-05};
__device__ __forceinline__ void p0_prologue(Frame& F) {
    LAS float* scr = (LAS float*)(F.lds + F.wave * 16384);
    const int gw = F.bid * NWAVES + F.wave, NGW = F.G * NWAVES;
    unsigned char* ws = ws_ptr();
    constexpr int E0 = 16 * 96, E1 = 16 * 32, E6 = 16, E7 = 32;
    constexpr int NEARLY = E0 + E1 + 2 * E6 + E7;
    for (int it = gw; it < NEARLY; it += NGW) {
        int r = it;
        if (r < E0) { tr_item(in_ptr(I_WIN), 1024, 6144, (bf16*)(ws + WS_WIN), 0, scr, (r / 96) * 192 + (r % 96), lane_id_asm(), nullptr); continue; } r -= E0;
        if (r < E1) { tr_item(in_ptr(I_WMKV), 1024, 1024, (bf16*)(ws + WS_WIN), 6144, scr, r, lane_id_asm(), nullptr); continue; } r -= E1;
        if (r < E6) { tr_item(in_ptr(I_W2), 64, 512, (bf16*)(ws + WS_W2T), 0, scr, r, lane_id_asm(), nullptr); continue; } r -= E6;
        if (r < E6) { tr_item(in_ptr(I_A2), 64, 512, (bf16*)(ws + WS_A2T), 0, scr, r, lane_id_asm(), nullptr); continue; } r -= E6;
        tr_item(in_ptr(I_G2), 128, 512, (bf16*)(ws + WS_G2T), 0, scr, r, lane_id_asm(), nullptr);
    }
    bf16* XN = (bf16*)(ws + WS_XN);
    {   const float* xp = in_ptr(I_XP); const float* xs = in_ptr(I_XS); const float* xm = in_ptr(I_MEM); const float* gmix = in_ptr(I_NMIX); const float* gmem = in_ptr(I_MEMN);
        for (int m = gw; m < MA; m += 2 * NGW) {
            int mm[2] = {m, (m + NGW < MA) ? m + NGW : m}; const float* xr[2]; const float* gr[2];
#pragma unroll
            for (int q = 0; q < 2; ++q) { const int r = mm[q];
                if (r < MPROMPT) { xr[q] = xp + (size_t)r * DM; gr[q] = gmix; } else if (r < MTOK) { xr[q] = xs + (size_t)(r - MPROMPT) * DM; gr[q] = gmix; }
                else if (r < MP) { xr[q] = nullptr; gr[q] = gmix; } else { xr[q] = xm + (size_t)(r - MP) * DM; gr[q] = gmem; } }
            if (xr[0] && xr[1]) rms_rows2_to_bf16(lane_id_asm(), xr[0], xr[1], gr[0], gr[1], XN + (size_t)mm[0] * DM, XN + (size_t)mm[1] * DM);
            else {
#pragma unroll
                for (int q = 0; q < 2; ++q) {
                    if (xr[q]) rms_rows2_to_bf16(lane_id_asm(), xr[q], xr[q], gr[q], gr[q], XN + (size_t)mm[q] * DM, XN + (size_t)mm[q] * DM);
                    else { GAS v4u* o = (GAS v4u*)(XN + (size_t)mm[q] * DM) + lane_id_asm(); o[0] = (v4u){0, 0, 0, 0}; o[64] = (v4u){0, 0, 0, 0}; } } }
        }
    }
    float* rope = (float*)(ws + WS_ROPE);
    for (int e = F.bid * 512 + (F.wave * 64 + lane_id_asm()); e < 8193 * 8; e += F.G * 512) {
        const int pos = e >> 3, i = e & 7; const double a = (double)pos * ROPE_INVF[i];
        const double n = __builtin_rint(a * 0.15915494309189535); const float r = (float)(a - n * 6.283185307179586);
        rope[pos * 16 + i] = cosf(r); rope[pos * 16 + 8 + i] = sinf(r);
    }
}
constexpr int NLATE = 16 * 96 + 3 * 8 * 32 + 16 * 32 + 16 * 128 + 64 * 32;
__device__ __forceinline__ void tr_late(int li, LAS float* scr) {
    unsigned char* ws = ws_ptr(); const int lane = lane_id_asm();
    constexpr int L0 = 16 * 96, L2 = 8 * 32, L3 = 16 * 32, L4 = 16 * 128;
    int r = li;
    if (r < L0) { tr_item(in_ptr(I_WIN), 1024, 6144, (bf16*)(ws + WS_WIN), 0, scr, (r / 96) * 192 + 96 + (r % 96), lane, nullptr); return; } r -= L0;
    if (r < L2) { tr_item(in_ptr(I_WBA), 512, 1024, (bf16*)(ws + WS_WBA), 0, scr, r, lane, nullptr); return; } r -= L2;
    if (r < L2) { tr_item(in_ptr(I_WBB), 512, 1024, (bf16*)(ws + WS_WBB), 0, scr, r, lane, nullptr); return; } r -= L2;
    if (r < L2) { tr_item(in_ptr(I_WBC), 512, 1024, (bf16*)(ws + WS_WBC), 0, scr, r, lane, nullptr); return; } r -= L2;
    if (r < L3) { tr_item(in_ptr(I_WOUT), 1024, 1024, (bf16*)(ws + WS_WOUT), 0, scr, r, lane, nullptr); return; } r -= L3;
    if (r < L4) { tr_item(in_ptr(I_WUP), 1024, 4096, (bf16*)(ws + WS_WUP), 0, scr, r, lane, in_ptr(I_NFFN)); return; } r -= L4;
    tr_item(in_ptr(I_WDN), 4096, 1024, (bf16*)(ws + WS_WDN), 0, scr, r, lane, nullptr);
}

struct P1Order {
    pg8::StaticOrder so;
    __device__ bool next(int i, pg8::Unit& u) const {
        long L = (long)i * so.G + so.c; if (L < so.nwg) return so.next(i, u);
        L -= so.nwg; if (L >= 8) return false; u.pm = 65 + (int)(L >> 2); u.pn = 24 + (int)(L & 3); return true;
    }
    __device__ __forceinline__ void a_ready(const pg8::Unit&) const {}
    __device__ __forceinline__ void done(const pg8::Unit&) const {}
};
using pg8::f32x4; using pg8::u32x4; using pg8::HALF; using pg8::BM;
#define EPI_LOOP_BEGIN  _Pragma("unroll") for (int ai = 0; ai < 2; ++ai) _Pragma("unroll") for (int m = 0; m < 4; ++m) { const int row = u.pm * BM + wr * 64 + fr + ai * HALF + m * 16; \
                        _Pragma("unroll") for (int bj = 0; bj < 2; ++bj) { const int col = u.pn * BM + wc * 32 + 8 * fq + bj * HALF; f32x4 v0 = acc[ai][bj][m][0], v1 = acc[ai][bj][m][1];
#define EPI_LOOP_END    } }
__device__ __forceinline__ u32x4 pack_acc(f32x4 v0, f32x4 v1) { u32x4 w; w.x = pg8::cvt_pk_bf16(v0[0], v0[1]); w.y = pg8::cvt_pk_bf16(v0[2], v0[3]); w.z = pg8::cvt_pk_bf16(v1[0], v1[1]); w.w = pg8::cvt_pk_bf16(v1[2], v1[3]); return w; }
struct EpiP1 {
    static constexpr bool PERM = true, AFTER_DRAIN = false;
    pg8::bf16_t* proj; pg8::bf16_t* kvb;
    __device__ __forceinline__ void operator()(const f32x4 (&acc)[2][2][4][2], const pg8::Unit& u, int wr, int wc, int fr, int fq) const {
        const bool memu = u.pm >= 65;
        EPI_LOOP_BEGIN
            const u32x4 w = pack_acc(v0, v1);
            if (memu) *(u32x4*)(kvb + (size_t)(row - 65 * BM) * 1024 + (col - 24 * BM)) = w;
            else *(u32x4*)(proj + (size_t)row * PC + col) = w;
        EPI_LOOP_END
    }
};
struct EpiGate {
    static constexpr bool PERM = true, AFTER_DRAIN = false;
    pg8::bf16_t* gate;
    __device__ __forceinline__ void operator()(const f32x4 (&acc)[2][2][4][2], const pg8::Unit& u, int wr, int wc, int fr, int fq) const {
        EPI_LOOP_BEGIN
#pragma unroll
            for (int e = 0; e < 4; ++e) { v0[e] = 1.f / (1.f + __expf(-v0[e])); v1[e] = 1.f / (1.f + __expf(-v1[e])); }
            *(u32x4*)(gate + (size_t)row * 1024 + col) = pack_acc(v0, v1);
        EPI_LOOP_END
    }
};
template <int MODE> struct EpiBr {
    static constexpr bool PERM = true, AFTER_DRAIN = false;
    const pg8::bf16_t* gate; float* macc; pg8::bf16_t* mrg;
    __device__ __forceinline__ void operator()(const f32x4 (&acc)[2][2][4][2], const pg8::Unit& u, int wr, int wc, int fr, int fq) const {
        EPI_LOOP_BEGIN
            const u32x4 gw = *(const u32x4*)(gate + (size_t)row * 1024 + col);
            float g[8]; unpack8((v4u){gw.x, gw.y, gw.z, gw.w}, g);
            pg8::bf16_t* mp = mrg + (size_t)row * 1024 + col;
            f32x4 a0 = (f32x4){g[0], g[1], g[2], g[3]} * v0, a1 = (f32x4){g[4], g[5], g[6], g[7]} * v1;
            if (MODE >= 1) { const u32x4 pw = *(const u32x4*)mp; float p[8]; unpack8((v4u){pw.x, pw.y, pw.z, pw.w}, p);
                a0 += (f32x4){p[0], p[1], p[2], p[3]}; a1 += (f32x4){p[4], p[5], p[6], p[7]}; }
            *(u32x4*)mp = pack_acc(a0, a1);
        EPI_LOOP_END
    }
};
struct EpiOut {
    static constexpr bool PERM = true, AFTER_DRAIN = false;
    const float* xp; const float* xs; float* out; pg8::bf16_t* x1b; float* sq;
    __device__ __forceinline__ void operator()(const f32x4 (&acc)[2][2][4][2], const pg8::Unit& u, int wr, int wc, int fr, int fq) const {
#pragma unroll
        for (int ai = 0; ai < 2; ++ai)
#pragma unroll
            for (int m = 0; m < 4; ++m) { const int row = u.pm * BM + wr * 64 + fr + ai * HALF + m * 16; float ss = 0.f;
                const float* xr = row < MPROMPT ? xp + (size_t)row * DM : xs + (size_t)(row - MPROMPT) * DM;
#pragma unroll
                for (int bj = 0; bj < 2; ++bj) { const int col = u.pn * BM + wc * 32 + 8 * fq + bj * HALF; f32x4 v0 = acc[ai][bj][m][0], v1 = acc[ai][bj][m][1];
                    if (row < MTOK) { v0 += *(const f32x4*)(xr + col); v1 += *(const f32x4*)(xr + col + 4);
                        *(f32x4*)(out + (size_t)row * DM + col) = v0; *(f32x4*)(out + (size_t)row * DM + col + 4) = v1; }
                    else { v0 = (f32x4){0.f, 0.f, 0.f, 0.f}; v1 = v0; }
                    ss += (v0[0] * v0[0] + v0[1] * v0[1]) + (v0[2] * v0[2] + v0[3] * v0[3]) + (v1[0] * v1[0] + v1[1] * v1[1]) + (v1[2] * v1[2] + v1[3] * v1[3]);
                    *(u32x4*)(x1b + (size_t)row * DM + col) = pack_acc(v0, v1); }
                ss += __shfl_xor(ss, 16); ss += __shfl_xor(ss, 32);
                if (fq == 0) sq[(size_t)row * 16 + u.pn * 4 + wc] = ss; }
    }
};
struct EpiUp {
    static constexpr bool PERM = true, AFTER_DRAIN = false;
    const float* sq; pg8::bf16_t* h;
    __device__ __forceinline__ void operator()(const f32x4 (&acc)[2][2][4][2], const pg8::Unit& u, int wr, int wc, int fr, int fq) const {
#pragma unroll
        for (int ai = 0; ai < 2; ++ai)
#pragma unroll
            for (int m = 0; m < 4; ++m) { const int row = u.pm * BM + wr * 64 + fr + ai * HALF + m * 16;
                const f32x4* sp = (const f32x4*)(sq + (size_t)row * 16); const f32x4 s0 = sp[0], s1 = sp[1], s2 = sp[2], s3 = sp[3];
                const float tot = ((s0[0] + s0[1]) + (s0[2] + s0[3])) + ((s1[0] + s1[1]) + (s1[2] + s1[3])) + ((s2[0] + s2[1]) + (s2[2] + s2[3])) + ((s3[0] + s3[1]) + (s3[2] + s3[3]));
                const float rstd = 1.f / sqrtf(tot * (1.f / 1024.f) + 1e-5f);
#pragma unroll
                for (int bj = 0; bj < 2; ++bj) { const int col = u.pn * BM + wc * 32 + 8 * fq + bj * HALF; f32x4 v0 = acc[ai][bj][m][0] * rstd, v1 = acc[ai][bj][m][1] * rstd;
#pragma unroll
                    for (int e = 0; e < 4; ++e) { const float a = fmaxf(v0[e], 0.f), b = fmaxf(v1[e], 0.f); v0[e] = a * a; v1[e] = b * b; }
                    *(u32x4*)(h + (size_t)row * 4096 + col) = pack_acc(v0, v1); } }
    }
};
struct EpiDown {
    static constexpr bool PERM = true, AFTER_DRAIN = false;
    float* out;
    __device__ __forceinline__ void operator()(const f32x4 (&acc)[2][2][4][2], const pg8::Unit& u, int wr, int wc, int fr, int fq) const {
        EPI_LOOP_BEGIN
            if (row < MTOK) { float* op = out + (size_t)row * DM + col; const f32x4 a0 = *(const f32x4*)op + v0, a1 = *(const f32x4*)(op + 4) + v1; *(f32x4*)op = a0; *(f32x4*)(op + 4) = a1; }
        EPI_LOOP_END
    }
};

template <class SE>
__device__ __forceinline__ void sgemm_block(Frame& F, const bf16* A, int lda, const bf16* Bt, int K, int n_rt, int n_ct, const SE& E) {
    const int lane = lane_id_asm(), c16 = lane & 15, gq = lane >> 4, w = F.wave;
    LAS f32x4* part = (LAS f32x4*)F.lds;
    const int ks = K >> 3;
    for (int bt = F.bid; bt < n_rt * n_ct; bt += F.G) {
        const int rt = bt % n_rt, ct = bt / n_rt;
        const bf16* ap = A + (size_t)(32 * rt + c16) * lda + w * ks + 8 * gq; const bf16* bp = Bt + (size_t)(32 * ct + c16) * K + w * ks + 8 * gq;
        f32x4 acc[2][2];
#pragma unroll
        for (int i = 0; i < 2; ++i)
#pragma unroll
            for (int j = 0; j < 2; ++j) acc[i][j] = (f32x4){0.f, 0.f, 0.f, 0.f};
#pragma unroll 4
        for (int s = 0; s < ks; s += 32) {
            const bf16x8 a0 = *(const bf16x8*)(ap + s), a1 = *(const bf16x8*)(ap + (size_t)16 * lda + s), b0 = *(const bf16x8*)(bp + s), b1 = *(const bf16x8*)(bp + (size_t)16 * K + s);
            acc[0][0] = MFMA16(a0, b0, acc[0][0]); acc[0][1] = MFMA16(a0, b1, acc[0][1]); acc[1][0] = MFMA16(a1, b0, acc[1][0]); acc[1][1] = MFMA16(a1, b1, acc[1][1]);
        }
#pragma unroll
        for (int q = 0; q < 4; ++q) part[(w * 4 + q) * 64 + lane] = acc[q >> 1][q & 1];
        __syncthreads();
        if (w < 4) { f32x4 v = part[w * 64 + lane];
#pragma unroll
            for (int o = 1; o < 8; ++o) v += part[(o * 4 + w) * 64 + lane];
            E.elem(32 * rt + 16 * (w >> 1) + 4 * gq, 32 * ct + 16 * (w & 1) + c16, v); }
        __syncthreads();
    }
}
struct SEpiBf16 { bf16* dst; int ldc;
    __device__ __forceinline__ void elem(int row, int col, f32x4 v) const {
#pragma unroll
        for (int r = 0; r < 4; ++r) dst[(size_t)(row + r) * ldc + col] = (bf16)f2bf(v[r]); } };
struct SEpiGate { bf16* gate;
    __device__ __forceinline__ void elem(int row, int col, f32x4 v) const {
#pragma unroll
        for (int r = 0; r < 4; ++r) gate[(size_t)(row + r) * 1024 + col] = (bf16)f2bf(1.f / (1.f + __expf(-v[r]))); } };
template <int MODE> struct SEpiBr { const bf16* gate; float* macc; bf16* mrg;
    __device__ __forceinline__ void elem(int row, int col, f32x4 v) const {
#pragma unroll
        for (int r = 0; r < 4; ++r) { const size_t o = (size_t)(row + r) * 1024 + col; float a = bf2f(gate[o]) * v[r];
            if (MODE >= 1) a += bf2f(mrg[o]);
            mrg[o] = (bf16)f2bf(a); } } };
struct SEpiOut { const float* xs; float* out; bf16* x1b; float* sqs;
    __device__ __forceinline__ void elem(int row, int col, f32x4 v) const {
#pragma unroll
        for (int r = 0; r < 4; ++r) { const size_t o = (size_t)(row + r) * 1024 + col; const float a = xs[o] + v[r]; out[o] = a; x1b[o] = (bf16)f2bf(a);
            float ss = a * a; ss += dpp_xor1(ss); ss += dpp_xor2(ss); ss += __builtin_bit_cast(float, __builtin_amdgcn_mov_dpp(__builtin_bit_cast(int, ss), 0x141, 0xF, 0xF, true));
            ss += __builtin_bit_cast(float, __builtin_amdgcn_mov_dpp(__builtin_bit_cast(int, ss), 0x140, 0xF, 0xF, true));
            if ((col & 15) == 0) atomicAdd(sqs + row + r, ss); } } };
struct SEpiUp { const float* sqs; bf16* h;
    __device__ __forceinline__ void elem(int row, int col, f32x4 v) const {
#pragma unroll
        for (int r = 0; r < 4; ++r) { const float rstd = 1.f / sqrtf(sqs[row + r] * (1.f / 1024.f) + 1e-5f); const float a = fmaxf(v[r] * rstd, 0.f); h[(size_t)(row + r) * 4096 + col] = (bf16)f2bf(a * a); } } };
struct SEpiDown { float* out;
    __device__ __forceinline__ void elem(int row, int col, f32x4 v) const {
#pragma unroll
        for (int r = 0; r < 4; ++r) out[(size_t)(row + r) * 1024 + col] += v[r]; } };

__device__ __forceinline__ void swa_unit(Frame& F, int b, int kvh, int qb) { unsigned char* wsp_ = ws_ptr(); float* outp_ = out_ptr(); const float* p_i_qn = in_ptr(I_QN); const float* p_i_kn = in_ptr(I_KN); const float* p_i_sink = in_ptr(I_SINK);
    LAS bf16* Ks = (LAS bf16*)F.lds; LAS bf16* Vt = Ks + 256 * 72;
    const bf16* proj = (const bf16*)(wsp_ + WS_PROJ); const float* rope = (const float*)(wsp_ + WS_ROPE);
    const int tid = (F.wave * 64 + lane_id_asm()), lane = lane_id_asm();
    {   const int sub = tid & 7; float gn[8];
#pragma unroll
        for (int j = 0; j < 8; ++j) gn[j] = p_i_kn[8 * sub + j];
#pragma unroll
        for (int pass = 0; pass < 4; ++pass) {
            const int kk = pass * 64 + (tid >> 3), tk = 128 * (qb - 1) + kk; const bool valid = tk >= 0; const size_t m = (size_t)b * TSEQ + (valid ? tk : 0);
            float x[8], vv[8]; unpack8(*(const v4u*)(proj + m * PC + C_K + 64 * kvh + 8 * sub), x); unpack8(*(const v4u*)(proj + m * PC + C_V + 64 * kvh + 8 * sub), vv);
            float ss = 0.f;
#pragma unroll
            for (int j = 0; j < 8; ++j) ss += x[j] * x[j];
            ss += __shfl_xor(ss, 1); ss += __shfl_xor(ss, 2); ss += __shfl_xor(ss, 4);
            const float rstd = 1.f / sqrtf(ss * (1.f / 64.f) + 1e-5f);
            const float* rp = rope + (size_t)(valid ? tk : 0) * 16;
#pragma unroll
            for (int j = 0; j < 8; ++j) { x[j] = x[j] * rstd * gn[j]; const float other = __shfl_xor(x[j], 1); const float c = rp[j], s = rp[8 + j];
                if (sub == 0) x[j] = x[j] * c - other * s; else if (sub == 1) x[j] = x[j] * c + other * s; }
            if (!valid) {
#pragma unroll
                for (int j = 0; j < 8; ++j) { x[j] = 0.f; vv[j] = 0.f; } }
            *(LAS v4u*)(Ks + kk * 72 + 8 * sub) = pack8(x);
#pragma unroll
            for (int j = 0; j < 8; ++j) Vt[(8 * sub + j) * 264 + kk] = (bf16)f2bf(vv[j]);
            if (qb == 63 && kk >= 128) { const size_t o = ((size_t)(b * 128 + (kk - 128)) * 2 + kvh) * 64 + 8 * sub;
#pragma unroll
                for (int j = 0; j < 8; ++j) { outp_[O_KP + o + j] = x[j]; outp_[O_VP + o + j] = vv[j]; } }
        }
    }
    __syncthreads();
    const int q = lane & 15, gq = lane >> 4;
    bf16* ob = (bf16*)(wsp_ + WS_OB);
    for (int mi = 0; mi < 4; ++mi) {
        const int mt = F.wave * 4 + mi, g = mt >> 3, tb = mt & 7, head = 4 * kvh + g;
        const int qi = 16 * tb + q, tq = 128 * qb + qi; const size_t m = (size_t)b * TSEQ + tq;
        float x0[8], x1[8]; unpack8(*(const v4u*)(proj + m * PC + C_Q + 64 * head + 8 * gq), x0); unpack8(*(const v4u*)(proj + m * PC + C_Q + 64 * head + 32 + 8 * gq), x1);
        float ss = 0.f;
#pragma unroll
        for (int j = 0; j < 8; ++j) ss += x0[j] * x0[j] + x1[j] * x1[j];
        ss += __shfl_xor(ss, 16); ss += __shfl_xor(ss, 32);
        const float rstd = 0.125f / sqrtf(ss * (1.f / 64.f) + 1e-5f);
        const float* rp = rope + (size_t)tq * 16;
#pragma unroll
        for (int j = 0; j < 8; ++j) { x0[j] = x0[j] * rstd * p_i_qn[8 * gq + j]; x1[j] = x1[j] * rstd * p_i_qn[32 + 8 * gq + j];
            const float other = __shfl_xor(x0[j], 16); const float c = rp[j], s = rp[8 + j];
            if (gq == 0) x0[j] = x0[j] * c - other * s; else if (gq == 1) x0[j] = x0[j] * c + other * s; }
        const bf16x8 qf0 = as_frag(pack8(x0)), qf1 = as_frag(pack8(x1));
        f32x4 acc[10];
#pragma unroll
        for (int kt = 0; kt < 9; ++kt) { const LAS bf16* kp = Ks + (16 * (tb + kt) + q) * 72 + 8 * gq;
            f32x4 a = (f32x4){0.f, 0.f, 0.f, 0.f};
            a = MFMA16(*(const LAS bf16x8*)kp, qf0, a); a = MFMA16(*(const LAS bf16x8*)(kp + 32), qf1, a); acc[kt] = a; __builtin_amdgcn_sched_barrier(0); }
        acc[9] = (f32x4){0.f, 0.f, 0.f, 0.f};
        const float sink = p_i_sink[head]; float mx = sink;
#pragma unroll
        for (int kt = 0; kt < 9; ++kt)
#pragma unroll
            for (int r = 0; r < 4; ++r) { const int kk = 16 * (tb + kt) + 4 * gq + r; const bool ok = kk >= qi && kk <= qi + 128 && (qb > 0 || kk >= 128);
                acc[kt][r] = ok ? acc[kt][r] : -INFINITY; mx = fmaxf(mx, acc[kt][r]); }
        mx = fmaxf(mx, __shfl_xor(mx, 16)); mx = fmaxf(mx, __shfl_xor(mx, 32));
        float ls = 0.f;
#pragma unroll
        for (int kt = 0; kt < 9; ++kt)
#pragma unroll
            for (int r = 0; r < 4; ++r) { const float p = __expf(acc[kt][r] - mx); acc[kt][r] = p; ls += p; }
        ls += __shfl_xor(ls, 16); ls += __shfl_xor(ls, 32); ls += __expf(sink - mx);
        f32x4 o[4];
#pragma unroll
        for (int dt = 0; dt < 4; ++dt) o[dt] = (f32x4){0.f, 0.f, 0.f, 0.f};
#pragma unroll
        for (int s = 0; s < 5; ++s) {
            v4u pw; pw.x = pk2(acc[2 * s][0], acc[2 * s][1]); pw.y = pk2(acc[2 * s][2], acc[2 * s][3]); pw.z = pk2(acc[2 * s + 1][0], acc[2 * s + 1][1]); pw.w = pk2(acc[2 * s + 1][2], acc[2 * s + 1][3]);
            const bf16x8 pf = as_frag(pw);
            const int t0 = tb + 2 * s, t1 = (t0 + 1 <= 15) ? t0 + 1 : 15;
#pragma unroll
            for (int dt = 0; dt < 4; ++dt) { const LAS bf16* vp = Vt + (16 * dt + q) * 264 + 4 * gq;
                typedef unsigned u32x2 __attribute__((ext_vector_type(2)));
                const u32x2 lo = *(const LAS u32x2*)(vp + 16 * t0), hi = *(const LAS u32x2*)(vp + 16 * t1);
                o[dt] = MFMA16(as_frag((v4u){lo.x, lo.y, hi.x, hi.y}), pf, o[dt]); }
            __builtin_amdgcn_sched_barrier(0);
        }
        const float il = 1.f / ls;
#pragma unroll
        for (int dt = 0; dt < 4; ++dt) { typedef unsigned u32x2 __attribute__((ext_vector_type(2)));
            u32x2 w; w.x = pk2(o[dt][0] * il, o[dt][1] * il); w.y = pk2(o[dt][2] * il, o[dt][3] * il);
            *(u32x2*)(ob + m * 512 + 64 * head + 16 * dt + 4 * gq) = w; }
    }
    __syncthreads();
}

__device__ __forceinline__ void mem_prep(Frame& F, int b, int hm) { unsigned char* wsp_ = ws_ptr(); float* outp_ = out_ptr(); const float* p_i_xkn = in_ptr(I_XKN);
    const bf16* kvb = (const bf16*)(wsp_ + WS_KVB);
    bf16* mkn = (bf16*)(wsp_ + WS_MKN) + (size_t)(b * 4 + hm) * 32768; bf16* mvt = (bf16*)(wsp_ + WS_MVT) + (size_t)(b * 4 + hm) * 32768;
    const int tid = (F.wave * 64 + lane_id_asm());
    const int sub = tid & 15; float gn[8];
#pragma unroll
    for (int j = 0; j < 8; ++j) gn[j] = p_i_xkn[8 * sub + j];
#pragma unroll 2
    for (int pass = 0; pass < 8; ++pass) {
        const int mm = pass * 32 + (tid >> 4); const size_t r = (size_t)(b * 256 + mm) * 1024 + 128 * hm + 8 * sub;
        float x[8], vv[8]; unpack8(*(const v4u*)(kvb + r), x); unpack8(*(const v4u*)(kvb + r + 512), vv);
        float ss = 0.f;
#pragma unroll
        for (int j = 0; j < 8; ++j) ss += x[j] * x[j];
        ss += __shfl_xor(ss, 1); ss += __shfl_xor(ss, 2); ss += __shfl_xor(ss, 4); ss += __shfl_xor(ss, 8);
        const float rstd = 1.f / sqrtf(ss * (1.f / 128.f) + 1e-5f);
#pragma unroll
        for (int j = 0; j < 8; ++j) x[j] = x[j] * rstd * gn[j];
        *(v4u*)(mkn + (size_t)mm * 128 + 8 * sub) = pack8(x);
#pragma unroll
        for (int j = 0; j < 8; ++j) mvt[(size_t)(8 * sub + j) * 256 + mm] = (bf16)f2bf(vv[j]);
        const size_t o = ((size_t)(b * 256 + mm) * 4 + hm) * 128 + 8 * sub;
#pragma unroll
        for (int j = 0; j < 8; ++j) { outp_[O_MKP + o + j] = x[j]; outp_[O_MVP + o + j] = vv[j]; }
    }
}

__device__ __forceinline__ void mem_unit(Frame& F, int b, int hm, int tb) { unsigned char* wsp_ = ws_ptr(); float* outp_ = out_ptr(); const float* p_i_xqn = in_ptr(I_XQN); const float* p_i_xkn = in_ptr(I_XKN);
    LAS bf16* Km = (LAS bf16*)F.lds; LAS bf16* Vt = Km + 256 * 136;
    const bf16* proj = (const bf16*)(wsp_ + WS_PROJ); const bf16* kvb = (const bf16*)(wsp_ + WS_KVB);
    const int tid = (F.wave * 64 + lane_id_asm()), lane = lane_id_asm();
    {   const bf16* mkn = (const bf16*)(wsp_ + WS_MKN) + (size_t)(b * 4 + hm) * 32768; const bf16* mvt = (const bf16*)(wsp_ + WS_MVT) + (size_t)(b * 4 + hm) * 32768;
        v4u kr[8], vr[8];
#pragma unroll
        for (int i = 0; i < 8; ++i) { const int c = tid + 512 * i; kr[i] = *(const v4u*)(mkn + (size_t)c * 8); vr[i] = *(const v4u*)(mvt + (size_t)c * 8); }
#pragma unroll
        for (int i = 0; i < 8; ++i) { const int c = tid + 512 * i;
            *(LAS v4u*)(Km + (c >> 4) * 136 + 8 * (c & 15)) = kr[i]; *(LAS v4u*)(Vt + (c >> 5) * 264 + 8 * (c & 31)) = vr[i]; }
    }
    __syncthreads();
    const int q = lane & 15, gq = lane >> 4;
    bf16* oc = (bf16*)(wsp_ + WS_OC);
    for (int mi = 0; mi < 2; ++mi) {
        const int mt = F.wave * 2 + mi; const size_t m = (size_t)b * TSEQ + 256 * tb + 16 * mt + q;
        bf16x8 qf[4];
        {   float x[4][8]; float ss = 0.f;
#pragma unroll
            for (int ks = 0; ks < 4; ++ks) { unpack8(*(const v4u*)(proj + m * PC + C_XQ + 128 * hm + 32 * ks + 8 * gq), x[ks]);
#pragma unroll
                for (int j = 0; j < 8; ++j) ss += x[ks][j] * x[ks][j]; }
            ss += __shfl_xor(ss, 16); ss += __shfl_xor(ss, 32);
            const float rstd = 0.08838834764831845f / sqrtf(ss * (1.f / 128.f) + 1e-5f);
#pragma unroll
            for (int ks = 0; ks < 4; ++ks) {
#pragma unroll
                for (int j = 0; j < 8; ++j) x[ks][j] = x[ks][j] * rstd * p_i_xqn[32 * ks + 8 * gq + j];
                qf[ks] = as_frag(pack8(x[ks])); }
        }
        f32x4 acc[16]; float mx = -INFINITY;
#pragma unroll
        for (int kt = 0; kt < 16; ++kt) { const LAS bf16* kp = Km + (16 * kt + q) * 136 + 8 * gq; f32x4 a = (f32x4){0.f, 0.f, 0.f, 0.f};
#pragma unroll
            for (int ks = 0; ks < 4; ++ks) a = MFMA16(*(const LAS bf16x8*)(kp + 32 * ks), qf[ks], a);
            acc[kt] = a; mx = fmaxf(mx, fmaxf(fmaxf(a[0], a[1]), fmaxf(a[2], a[3]))); __builtin_amdgcn_sched_barrier(0); }
        mx = fmaxf(mx, __shfl_xor(mx, 16)); mx = fmaxf(mx, __shfl_xor(mx, 32));
        float ls = 0.f;
#pragma unroll
        for (int kt = 0; kt < 16; ++kt)
#pragma unroll
            for (int r = 0; r < 4; ++r) { const float p = __expf(acc[kt][r] - mx); acc[kt][r] = p; ls += p; }
        ls += __shfl_xor(ls, 16); ls += __shfl_xor(ls, 32);
        f32x4 o[8];
#pragma unroll
        for (int dt = 0; dt < 8; ++dt) o[dt] = (f32x4){0.f, 0.f, 0.f, 0.f};
#pragma unroll
        for (int s = 0; s < 8; ++s) {
            v4u pw; pw.x = pk2(acc[2 * s][0], acc[2 * s][1]); pw.y = pk2(acc[2 * s][2], acc[2 * s][3]); pw.z = pk2(acc[2 * s + 1][0], acc[2 * s + 1][1]); pw.w = pk2(acc[2 * s + 1][2], acc[2 * s + 1][3]);
            const bf16x8 pf = as_frag(pw);
#pragma unroll
            for (int dt = 0; dt < 8; ++dt) { const LAS bf16* vp = Vt + (16 * dt + q) * 264 + 32 * s + 4 * gq;
                typedef unsigned u32x2 __attribute__((ext_vector_type(2)));
                const u32x2 lo = *(const LAS u32x2*)vp, hi = *(const LAS u32x2*)(vp + 16);
                o[dt] = MFMA16(as_frag((v4u){lo.x, lo.y, hi.x, hi.y}), pf, o[dt]); }
            __builtin_amdgcn_sched_barrier(0);
        }
        const float il = 1.f / ls;
#pragma unroll
        for (int dt = 0; dt < 8; ++dt) { typedef unsigned u32x2 __attribute__((ext_vector_type(2)));
            u32x2 w; w.x = pk2(o[dt][0] * il, o[dt][1] * il); w.y = pk2(o[dt][2] * il, o[dt][3] * il);
            *(u32x2*)(oc + m * 512 + 128 * hm + 16 * dt + 4 * gq) = w; }
    }
    __syncthreads();
}

template <int CTRL> __device__ __forceinline__ float dppq2(float x) { return __builtin_bit_cast(float, __builtin_amdgcn_mov_dpp(__builtin_bit_cast(int, x), CTRL, 0xF, 0xF, true)); }
template <int CTRL, int RM> __device__ __forceinline__ float dppk2(float x) { return __builtin_bit_cast(float, __builtin_amdgcn_update_dpp(__builtin_bit_cast(int, x), __builtin_bit_cast(int, x), CTRL, RM, 0xF, false)); }
template <int CTRL, int RM> __device__ __forceinline__ float dppz2(float x) { return __builtin_bit_cast(float, __builtin_amdgcn_update_dpp(0, __builtin_bit_cast(int, x), CTRL, RM, 0xF, false)); }
__device__ __forceinline__ float wsum2(float v) { v += dppq2<0xB1>(v); v += dppq2<0x4E>(v); v += dppq2<0x141>(v); v += dppq2<0x140>(v); v += dppz2<0x142, 0xA>(v); v += dppz2<0x143, 0xC>(v);
    return __builtin_bit_cast(float, __builtin_amdgcn_readlane(__builtin_bit_cast(int, v), 63)); }
__device__ __forceinline__ float wmax2(float v) { v = fmaxf(v, dppq2<0xB1>(v)); v = fmaxf(v, dppq2<0x4E>(v)); v = fmaxf(v, dppq2<0x141>(v)); v = fmaxf(v, dppq2<0x140>(v)); v = fmaxf(v, dppk2<0x142, 0xA>(v)); v = fmaxf(v, dppk2<0x143, 0xC>(v));
    return __builtin_bit_cast(float, __builtin_amdgcn_readlane(__builtin_bit_cast(int, v), 63)); }
__device__ __forceinline__ void swa_sample_task(Frame& F, LAS float* wl, int bs, int kvh) { unsigned char* wsp_ = ws_ptr(); float* outp_ = out_ptr(); const float* p_i_ck = in_ptr(I_CK); const float* p_i_cv = in_ptr(I_CV); const float* p_i_qn = in_ptr(I_QN); const float* p_i_kn = in_ptr(I_KN); const float* p_i_sink = in_ptr(I_SINK);
    int lane = lane_id_asm(); asm volatile("" : "+v"(lane)); const size_t m = MPROMPT + bs;
    const bf16* prow = (const bf16*)(wsp_ + WS_PROJ) + m * PC; const float* rp = (const float*)(wsp_ + WS_ROPE) + (size_t)8192 * 16;
    LAS float* qs = wl;
    LAS float* kn = wl + 256;
    LAS float* vn = wl + 320;
    LAS float* pp = wl + 384;
    const float* ck = p_i_ck + (size_t)bs * 16384 + 64 * kvh; const float* cv = p_i_cv + (size_t)bs * 16384 + 64 * kvh;
    float* ok = outp_ + O_KS + (size_t)bs * 16384 + 64 * kvh; float* ov = outp_ + O_VS + (size_t)bs * 16384 + 64 * kvh;
    const float c = rp[lane & 7], s = rp[8 + (lane & 7)];
#pragma unroll
    for (int h = 0; h < 5; ++h) {
        const float x = bf2f(h < 4 ? prow[C_Q + 64 * (4 * kvh + h) + lane] : prow[C_K + 64 * kvh + lane]);
        const float rstd = __builtin_amdgcn_rsqf(wsum2(x * x) * (1.f / 64.f) + 1e-5f);
        float y = x * rstd * (h < 4 ? p_i_qn[lane] : p_i_kn[lane]);
        const float other = __shfl_xor(y, 8);
        if (lane < 8) y = y * c - other * s; else if (lane < 16) y = y * c + other * s;
        if (h < 4) qs[64 * h + lane] = y * 0.125f; else { kn[lane] = y; ok[127 * 128 + lane] = y; }
    }
    { const float v = bf2f(prow[C_V + 64 * kvh + lane]); vn[lane] = v; ov[127 * 128 + lane] = v; }
    float sc[2][4];
#pragma unroll
    for (int ps = 0; ps < 2; ++ps) { const float* kr = ck + (size_t)(lane + 64 * ps) * 128; float a0 = 0.f, a1 = 0.f, a2 = 0.f, a3 = 0.f;
#pragma unroll 8
        for (int d4 = 0; d4 < 16; ++d4) { const f32x4 k4 = *(const f32x4*)(kr + 4 * d4);
            const f32x4 q0 = *(const LAS f32x4*)(qs + 4 * d4), q1 = *(const LAS f32x4*)(qs + 64 + 4 * d4), q2 = *(const LAS f32x4*)(qs + 128 + 4 * d4), q3 = *(const LAS f32x4*)(qs + 192 + 4 * d4);
            a0 += k4[0] * q0[0] + k4[1] * q0[1] + k4[2] * q0[2] + k4[3] * q0[3]; a1 += k4[0] * q1[0] + k4[1] * q1[1] + k4[2] * q1[2] + k4[3] * q1[3];
            a2 += k4[0] * q2[0] + k4[1] * q2[1] + k4[2] * q2[2] + k4[3] * q2[3]; a3 += k4[0] * q3[0] + k4[1] * q3[1] + k4[2] * q3[2] + k4[3] * q3[3]; }
        sc[ps][0] = a0; sc[ps][1] = a1; sc[ps][2] = a2; sc[ps][3] = a3; }
    float linv[4];
#pragma unroll
    for (int h = 0; h < 4; ++h) {
        const float sn = wsum2(qs[64 * h + lane] * kn[lane]); const float sink = p_i_sink[4 * kvh + h];
        const float mx = fmaxf(fmaxf(wmax2(fmaxf(sc[0][h], sc[1][h])), sn), sink);
        const float p0 = __expf(sc[0][h] - mx), p1 = __expf(sc[1][h] - mx), pn = __expf(sn - mx);
        const float l = wsum2(p0 + p1) + pn + __expf(sink - mx);
        pp[132 * h + lane] = p0; pp[132 * h + 64 + lane] = p1; if (lane == 0) pp[132 * h + 128] = pn; linv[h] = 1.f / l;
    }
    bf16* ob = (bf16*)(wsp_ + WS_OB) + m * 512 + 256 * kvh;
    float o0 = 0.f, o1 = 0.f, o2 = 0.f, o3 = 0.f;
#pragma unroll 16
    for (int key = 0; key < 128; ++key) { const float v = cv[(size_t)key * 128 + lane];
        o0 += pp[key] * v; o1 += pp[132 + key] * v; o2 += pp[264 + key] * v; o3 += pp[396 + key] * v; }
    { const float v = vn[lane]; o0 += pp[128] * v; o1 += pp[132 + 128] * v; o2 += pp[264 + 128] * v; o3 += pp[396 + 128] * v; }
    ob[lane] = (bf16)f2bf(o0 * linv[0]); ob[64 + lane] = (bf16)f2bf(o1 * linv[1]); ob[128 + lane] = (bf16)f2bf(o2 * linv[2]); ob[192 + lane] = (bf16)f2bf(o3 * linv[3]);
}
__device__ __forceinline__ void swa_copy_task(int bs) { float* outp_ = out_ptr(); const float* ck = in_ptr(I_CK) + (size_t)bs * 16384; const float* cv = in_ptr(I_CV) + (size_t)bs * 16384;
    float* ok = outp_ + O_KS + (size_t)bs * 16384; float* ov = outp_ + O_VS + (size_t)bs * 16384;
    int lane = lane_id_asm(); asm volatile("" : "+v"(lane));
#pragma unroll 8
    for (int i = lane; i < 127 * 32; i += 64) { ((f32x4*)ok)[i] = ((const f32x4*)ck)[i + 32]; ((f32x4*)ov)[i] = ((const f32x4*)cv)[i + 32]; }
}
__device__ __forceinline__ void mem_sample_task(Frame& F, LAS float* wl, int bs, int hm) { unsigned char* wsp_ = ws_ptr(); const float* p_i_cmk = in_ptr(I_CMK); const float* p_i_cmv = in_ptr(I_CMV); const float* p_i_xqn = in_ptr(I_XQN);
    int lane = lane_id_asm(); asm volatile("" : "+v"(lane)); const size_t m = MPROMPT + bs;
    const bf16* prow = (const bf16*)(wsp_ + WS_PROJ) + m * PC;
    LAS float* sc = wl;
    const int half = lane >> 5, d4 = 4 * (lane & 31);
    float q4[4];
    {   float x[4]; float ss = 0.f;
#pragma unroll
        for (int e = 0; e < 4; ++e) { x[e] = bf2f(prow[C_XQ + 128 * hm + d4 + e]); ss += x[e] * x[e]; }
        ss += __shfl_xor(ss, 1); ss += __shfl_xor(ss, 2); ss += __shfl_xor(ss, 4); ss += __shfl_xor(ss, 8); ss += __shfl_xor(ss, 16);
        const float rstd = 0.08838834764831845f / sqrtf(ss * (1.f / 128.f) + 1e-5f);
#pragma unroll
        for (int e = 0; e < 4; ++e) q4[e] = x[e] * rstd * p_i_xqn[d4 + e]; }
    const float* kb = p_i_cmk + ((size_t)bs * 256 * 4 + hm) * 128 + d4; const float* vb = p_i_cmv + ((size_t)bs * 256 * 4 + hm) * 128 + d4;
#pragma unroll 4
    for (int i = 0; i < 128; i += 4) {
        float part[4];
#pragma unroll
        for (int u = 0; u < 4; ++u) { const f32x4 k4 = *(const f32x4*)(kb + (size_t)(2 * (i + u) + half) * 512); part[u] = k4[0] * q4[0] + k4[1] * q4[1] + k4[2] * q4[2] + k4[3] * q4[3]; }
#pragma unroll
        for (int u = 0; u < 4; ++u) { float p = part[u]; p += dppq2<0xB1>(p); p += dppq2<0x4E>(p); p += dppq2<0x141>(p); p += dppq2<0x140>(p); p += __shfl_xor(p, 16);
            if ((lane & 31) == 0) sc[2 * (i + u) + half] = p; }
    }
    float s4[4]; float mx = -INFINITY;
#pragma unroll
    for (int e = 0; e < 4; ++e) { s4[e] = sc[lane + 64 * e]; mx = fmaxf(mx, s4[e]); }
    mx = wave_max(mx); float l = 0.f;
#pragma unroll
    for (int e = 0; e < 4; ++e) { s4[e] = __expf(s4[e] - mx); l += s4[e]; }
    l = wave_sum(l);
#pragma unroll
    for (int e = 0; e < 4; ++e) sc[lane + 64 * e] = s4[e];
    f32x4 o = (f32x4){0.f, 0.f, 0.f, 0.f};
#pragma unroll 4
    for (int i = 0; i < 128; i += 4) {
#pragma unroll
        for (int u = 0; u < 4; ++u) { const int key = 2 * (i + u) + half; const f32x4 v4 = *(const f32x4*)(vb + (size_t)key * 512); o += v4 * sc[key]; }
    }
#pragma unroll
    for (int e = 0; e < 4; ++e) o[e] += __shfl_xor(o[e], 32);
    if (half == 0) { const float il = 1.f / l; typedef unsigned u32x2 __attribute__((ext_vector_type(2)));
        u32x2 w; w.x = pk2(o[0] * il, o[1] * il); w.y = pk2(o[2] * il, o[3] * il);
        *(u32x2*)((bf16*)(wsp_ + WS_OC) + m * 512 + 128 * hm + d4) = w; }
}

template <int CTRL> __device__ __forceinline__ float dppq(float x) { return __builtin_bit_cast(float, __builtin_amdgcn_mov_dpp(__builtin_bit_cast(int, x), CTRL, 0xF, 0xF, true)); }
template <int CTRL, int RM> __device__ __forceinline__ float dpp0(float x) { return __builtin_bit_cast(float, __builtin_amdgcn_update_dpp(0, __builtin_bit_cast(int, x), CTRL, RM, 0xF, false)); }
__device__ __forceinline__ float wave_sum_fast(float v) {
    v += dppq<0xB1>(v); v += dppq<0x4E>(v); v += dppq<0x141>(v); v += dppq<0x140>(v);
    v += dpp0<0x142, 0xA>(v); v += dpp0<0x143, 0xC>(v);
    return __builtin_bit_cast(float, __builtin_amdgcn_readlane(__builtin_bit_cast(int, v), 63));
}
template <int MODE>
__device__ __forceinline__ void rwkv_task(Frame& F, LAS float* wl, int h, int m0, int t0, int ngrp, float* lbuf, bf16* pth, bf16* ptl, float* s_out, int sub_lo, int sub_hi) { unsigned char* wsp_ = ws_ptr(); float* outp_ = out_ptr(); const float* p_i_srw = in_ptr(I_SRW); const float* p_i_shift = in_ptr(I_SHIFT); const float* p_i_mu = in_ptr(I_MU); const float* p_i_w0 = in_ptr(I_W0); const float* p_i_a0 = in_ptr(I_A0); const float* p_i_kk = in_ptr(I_KK); const float* p_i_ka = in_ptr(I_KA); const float* p_i_rk = in_ptr(I_RK); const float* p_i_lnw = in_ptr(I_LNW); const float* p_i_lnb = in_ptr(I_LNB);
    constexpr bool SAMPLE = (MODE == 0);
    const int lane0 = lane_id_asm(); const int ch = 64 * h + lane0;
    const bf16* proj = (const bf16*)(wsp_ + WS_PROJ);
    const bf16* w2t = (const bf16*)(wsp_ + WS_W2T); const bf16* a2t = (const bf16*)(wsp_ + WS_A2T); const bf16* g2t = (const bf16*)(wsp_ + WS_G2T);
    const float* mu = p_i_mu;
    LAS float* dec = wl; LAS float* aa = wl + 1024; LAS bf16* gg = (LAS bf16*)(wl + 2048); LAS float* vec = wl + 2560; LAS float* ybuf = wl + 4096; LAS float* bonl = wl + 4352;
    const float mu_r = mu[ch], mu_k = mu[512 + ch], mu_v = mu[1024 + ch], kk_c = p_i_kk[ch], ka_c = p_i_ka[ch], rk_c = p_i_rk[ch], lnw = p_i_lnw[ch], lnb = p_i_lnb[ch];
    typedef float f2 __attribute__((ext_vector_type(2)));
    f2 S2[4][8]; f2 Pm2[MODE == 1 ? 4 : 1][8];
    {   const int vb = lane0 >> 2, kb = lane0 & 3;
#pragma unroll
        for (int i = 0; i < 4; ++i)
#pragma unroll
            for (int j = 0; j < 16; ++j) { S2[i][j >> 1][j & 1] = 0.f; if (MODE == 1) Pm2[i][j >> 1][j & 1] = (4 * vb + i == 16 * kb + j) ? 1.f : 0.f; }
        if (MODE == 2 && lbuf) { const float* sp = lbuf + (size_t)(4 * vb) * 64 + 16 * kb;
#pragma unroll
            for (int i = 0; i < 4; ++i)
#pragma unroll
                for (int q4 = 0; q4 < 4; ++q4) { const f32x4 t = *(const f32x4*)(sp + i * 64 + 4 * q4); S2[i][2 * q4] = (f2){t[0], t[1]}; S2[i][2 * q4 + 1] = (f2){t[2], t[3]}; } }
    }
    bf16* oa = (bf16*)(wsp_ + WS_OA);
#pragma unroll 1
    for (int grp = 0; grp < ngrp; ++grp) {
        {   int ln = lane0; asm volatile("" : "+v"(ln)); const int c16 = ln & 15, gq = ln >> 4;
            const int m = m0 + 16 * grp + c16; const bool first = (!SAMPLE) && (t0 + 16 * grp + c16 == 0);
            bf16x8 af[8]; const float* mup = mu; asm volatile("" : "+s"(mup));
#pragma unroll
            for (int f = 0; f < 8; ++f) {
                const int col = 1536 + 32 * f + 8 * gq;
                float z[8], zp[8]; unpack8(*(const v4u*)(proj + (size_t)m * PC + col), z);
                if (SAMPLE) { const float* sp = p_i_shift + (size_t)(m - MPROMPT) * ZC + col; const f32x4 a = *(const f32x4*)sp, b = *(const f32x4*)(sp + 4);
                    zp[0] = a[0]; zp[1] = a[1]; zp[2] = a[2]; zp[3] = a[3]; zp[4] = b[0]; zp[5] = b[1]; zp[6] = b[2]; zp[7] = b[3]; }
                else { unpack8(*(const v4u*)(proj + (size_t)(first ? m : m - 1) * PC + col), zp);
                    if (first) {
#pragma unroll
                        for (int j = 0; j < 8; ++j) zp[j] = 0.f; } }
                const f32x4 m0v = *(const f32x4*)(mup + col), m1v = *(const f32x4*)(mup + col + 4);
#pragma unroll
                for (int j = 0; j < 8; ++j) { const float mj = j < 4 ? m0v[j] : m1v[j - 4]; float v = z[j] + (zp[j] - z[j]) * mj;
                    if (f < 2) { const float e2 = __expf(2.f * v); v = 1.f - 2.f * __builtin_amdgcn_rcpf(e2 + 1.f); } else if (f >= 4) v = __builtin_amdgcn_rcpf(1.f + __expf(-v)); z[j] = v; }
                af[f] = as_frag(pack8(z));
            }
#pragma unroll
            for (int nt = 0; nt < 4; ++nt) { const int n = 64 * h + 16 * nt + c16;
                const bf16* wp = w2t + n * 64 + 8 * gq; const bf16* ap = a2t + n * 64 + 8 * gq; const bf16* gp = g2t + n * 128 + 8 * gq;
                f32x4 accw = (f32x4){0.f, 0.f, 0.f, 0.f}, acca = accw, accg = accw;
                accw = MFMA16(af[0], *(const bf16x8*)wp, accw); accw = MFMA16(af[1], *(const bf16x8*)(wp + 32), accw);
                acca = MFMA16(af[2], *(const bf16x8*)ap, acca); acca = MFMA16(af[3], *(const bf16x8*)(ap + 32), acca);
                if (MODE != 1) {
#pragma unroll
                    for (int f = 0; f < 4; ++f) accg = MFMA16(af[4 + f], *(const bf16x8*)(gp + 32 * f), accg); }
                const float w0v = p_i_w0[n], a0v = p_i_a0[n];
#pragma unroll
                for (int r = 0; r < 4; ++r) { const int tl = 4 * gq + r, cc = 16 * nt + c16;
                    const float x = -(w0v + accw[r]);
                    const float sp = fmaxf(x, 0.f) + __logf(1.f + __expf(-fabsf(x)));
                    dec[tl * 64 + cc] = __expf(-__expf(-sp - 0.5f));
                    aa[tl * 64 + cc] = __builtin_amdgcn_rcpf(1.f + __expf(-(a0v + acca[r])));
                    if (MODE != 1) gg[tl * 64 + cc] = (bf16)f2bf(accg[r]); }
            }
        }
#define RW_LOADZ(SUB) do { _Pragma("unroll") for (int tt = 0; tt < 4; ++tt) { const int tl_ = 4 * (SUB) + tt, m_ = m0 + 16 * grp + tl_; const bf16* zr = proj + (size_t)m_ * PC + ch; \
            cz[tt][0] = MODE == 1 ? 0.f : bf2f(zr[0]); cz[tt][1] = bf2f(zr[512]); cz[tt][2] = bf2f(zr[1024]); \
            if (SAMPLE) { const float* sp = p_i_shift + (size_t)(m_ - MPROMPT) * ZC + ch; pz[tt][0] = sp[0]; pz[tt][1] = sp[512]; pz[tt][2] = sp[1024]; } \
            else if (t0 + 16 * grp + tl_ == 0) { pz[tt][0] = 0.f; pz[tt][1] = 0.f; pz[tt][2] = 0.f; } \
            else { pz[tt][0] = MODE == 1 ? 0.f : bf2f(zr[-PC]); pz[tt][1] = bf2f(zr[512 - PC]); pz[tt][2] = bf2f(zr[1024 - PC]); } } } while (0)
        float cz[4][3], pz[4][3];
        RW_LOADZ(sub_lo);
#pragma unroll 1
        for (int sub = sub_lo; sub < sub_hi; ++sub) {
            int lane = lane0; asm volatile("" : "+v"(lane)); const int vb = lane >> 2, kb = lane & 3;
#pragma unroll
            for (int tt = 0; tt < 4; ++tt) {
                const int tl = 4 * sub + tt;
                const float r = cz[tt][0] + (pz[tt][0] - cz[tt][0]) * mu_r, k = cz[tt][1] + (pz[tt][1] - cz[tt][1]) * mu_k, v = cz[tt][2] + (pz[tt][2] - cz[tt][2]) * mu_v;
                const float a = aa[tl * 64 + lane], d = dec[tl * 64 + lane];
                const float kk0 = k * kk_c; const float kk = kk0 * __builtin_amdgcn_rsqf(fmaxf(wave_sum_fast(kk0 * kk0), 1e-24f));
                const float kh = k * (1.f + (a - 1.f) * ka_c);
                LAS float* vp = vec + tt * 384;
                vp[lane] = d; vp[64 + lane] = kk; vp[128 + lane] = kk * a; vp[192 + lane] = kh; if (MODE != 1) vp[256 + lane] = r; vp[320 + lane] = v;
                if (MODE != 1) { const float bon = wave_sum_fast(r * kh * rk_c); if (lane == 0) bonl[tt] = bon; }
            }
            if (sub + 1 < sub_hi) RW_LOADZ(sub + 1);
#pragma unroll 1
            for (int tt = 0; tt < 4; ++tt) {
                const int tl = 4 * sub + tt, m = m0 + 16 * grp + tl;
                if (SAMPLE) { const float* sp = p_i_srw + (((size_t)(m - MPROMPT) * 8 + h) * 64 + 4 * vb) * 64 + 16 * kb;
#pragma unroll
                    for (int i = 0; i < 4; ++i)
#pragma unroll
                        for (int q4 = 0; q4 < 4; ++q4) { const f32x4 t = *(const f32x4*)(sp + i * 64 + 4 * q4); S2[i][2 * q4] = (f2){t[0], t[1]}; S2[i][2 * q4 + 1] = (f2){t[2], t[3]}; } }
                const LAS float* vp = vec + tt * 384 + 16 * kb;
                f2 w2[8], kk2[8], b2[8], k2[8], r2[8];
#pragma unroll
                for (int q4 = 0; q4 < 4; ++q4) { const f32x4 t0v = *(const LAS f32x4*)(vp + 4 * q4), t1 = *(const LAS f32x4*)(vp + 64 + 4 * q4), t2 = *(const LAS f32x4*)(vp + 128 + 4 * q4),
                        t3 = *(const LAS f32x4*)(vp + 192 + 4 * q4);
                    w2[2 * q4] = (f2){t0v[0], t0v[1]}; w2[2 * q4 + 1] = (f2){t0v[2], t0v[3]}; kk2[2 * q4] = (f2){t1[0], t1[1]}; kk2[2 * q4 + 1] = (f2){t1[2], t1[3]};
                    b2[2 * q4] = (f2){t2[0], t2[1]}; b2[2 * q4 + 1] = (f2){t2[2], t2[3]}; k2[2 * q4] = (f2){t3[0], t3[1]}; k2[2 * q4 + 1] = (f2){t3[2], t3[3]};
                    if (MODE != 1) { const f32x4 t4 = *(const LAS f32x4*)(vp + 256 + 4 * q4); r2[2 * q4] = (f2){t4[0], t4[1]}; r2[2 * q4 + 1] = (f2){t4[2], t4[3]}; } }
                const f32x4 v4 = *(const LAS f32x4*)(vec + tt * 384 + 320 + 4 * vb);
                f32x4 yv;
#pragma unroll
                for (int i = 0; i < 4; ++i) { f2 a2 = (f2){0.f, 0.f};
#pragma unroll
                    for (int j = 0; j < 8; ++j) a2 += S2[i][j] * kk2[j];
                    float a = a2.x + a2.y; a += dpp_xor1(a); a += dpp_xor2(a); const float sa = -a; const float vi = v4[i];
                    const f2 sa2 = (f2){sa, sa}, vi2 = (f2){vi, vi}; f2 y2 = (f2){0.f, 0.f};
#pragma unroll
                    for (int j = 0; j < 8; ++j) { S2[i][j] = S2[i][j] * w2[j] + sa2 * b2[j] + vi2 * k2[j]; if (MODE != 1) y2 += S2[i][j] * r2[j]; }
                    if (MODE != 1) { float y = y2.x + y2.y; y += dpp_xor1(y); y += dpp_xor2(y); yv[i] = y; }
                    if (MODE == 1) { f2 p2 = (f2){0.f, 0.f};
#pragma unroll
                        for (int j = 0; j < 8; ++j) p2 += Pm2[i][j] * kk2[j];
                        float pa = p2.x + p2.y; pa += dpp_xor1(pa); pa += dpp_xor2(pa); pa = -pa; const f2 pa2 = (f2){pa, pa};
#pragma unroll
                        for (int j = 0; j < 8; ++j) Pm2[i][j] = Pm2[i][j] * w2[j] + pa2 * b2[j]; } }
                if (MODE != 1 && kb == 0) *(LAS f32x4*)(ybuf + tt * 64 + 4 * vb) = yv;
                if (SAMPLE) { float* sp = outp_ + O_SS + (((size_t)(m - MPROMPT) * 8 + h) * 64 + 4 * vb) * 64 + 16 * kb;
#pragma unroll
                    for (int i = 0; i < 4; ++i)
#pragma unroll
                        for (int q4 = 0; q4 < 4; ++q4) *(f32x4*)(sp + i * 64 + 4 * q4) = (f32x4){S2[i][2 * q4].x, S2[i][2 * q4].y, S2[i][2 * q4 + 1].x, S2[i][2 * q4 + 1].y}; }
            }
            if (MODE != 1) {
#pragma unroll
                for (int tt = 0; tt < 4; ++tt) {
                    const int tl = 4 * sub + tt, m = m0 + 16 * grp + tl;
                    const float y = ybuf[tt * 64 + lane]; const float mean = wave_sum_fast(y) * (1.f / 64.f); const float dd = y - mean;
                    const float var = wave_sum_fast(dd * dd) * (1.f / 64.f);
                    const float yn = dd * __builtin_amdgcn_rsqf(var + 64e-5f) * lnw + lnb;
                    const float o = (yn + bonl[tt] * vec[tt * 384 + 320 + lane]) * bf2f(gg[tl * 64 + lane]);
                    oa[(size_t)m * 512 + ch] = (bf16)f2bf(o);
                }
            }
        }
    }
    {   const int vb = lane0 >> 2, kb = lane0 & 3;
        if (MODE == 2 && s_out) { float* sp = s_out + (size_t)(4 * vb) * 64 + 16 * kb;
#pragma unroll
            for (int i = 0; i < 4; ++i)
#pragma unroll
                for (int q4 = 0; q4 < 4; ++q4) *(f32x4*)(sp + i * 64 + 4 * q4) = (f32x4){S2[i][2 * q4].x, S2[i][2 * q4].y, S2[i][2 * q4 + 1].x, S2[i][2 * q4 + 1].y}; }
        if (MODE == 1) { float* sp = lbuf + (size_t)(4 * vb) * 64 + 16 * kb;
#pragma unroll
            for (int i = 0; i < 4; ++i)
#pragma unroll
                for (int q4 = 0; q4 < 4; ++q4) *(f32x4*)(sp + i * 64 + 4 * q4) = (f32x4){S2[i][2 * q4].x, S2[i][2 * q4].y, S2[i][2 * q4 + 1].x, S2[i][2 * q4 + 1].y};
            const int p0 = 32 * (vb >> 3) + 8 * (vb & 3) + 4 * ((vb >> 2) & 1);
#pragma unroll
            for (int j = 0; j < 16; ++j) { typedef unsigned u32x2 __attribute__((ext_vector_type(2)));
                unsigned hi[4]; float lo[4];
#pragma unroll
                for (int i = 0; i < 4; ++i) { hi[i] = f2bf(Pm2[i][j >> 1][j & 1]); lo[i] = Pm2[i][j >> 1][j & 1] - __builtin_bit_cast(float, hi[i] << 16); }
                u32x2 wh, wlo; wh.x = hi[0] | (hi[1] << 16); wh.y = hi[2] | (hi[3] << 16); wlo.x = pk2(lo[0], lo[1]); wlo.y = pk2(lo[2], lo[3]);
                *(u32x2*)(pth + (size_t)(16 * kb + j) * 64 + p0) = wh; (void)wlo; (void)ptl; }
        }
    }
}
__device__ __forceinline__ void rwkv_combine(Frame& F, int chain) {
    const int lane = lane_id_asm(), v = lane & 15, gq = lane >> 4, w = F.wave, tid = w * 64 + lane;
    float* lbase = out_ptr() + (size_t)chain * 128 * 4096;
    const bf16* phg = (const bf16*)(out_ptr() + (size_t)2048 * 4096) + (size_t)chain * 128 * 4096;
    constexpr int SLOT = 26624, OFF_L = 9216;
    const int prow = tid >> 3, pch = tid & 7; const size_t pg = (size_t)prow * 64 + 8 * pch; const int pl_ = (prow * 72 + 8 * pch) * 2;
    const int lr0 = tid >> 4, lc = tid & 15; const size_t lg0 = (size_t)lr0 * 64 + 4 * lc, lg1 = lg0 + (size_t)32 * 64; const int ll0 = OFF_L + (lr0 * 68 + 4 * lc) * 4, ll1 = ll0 + 32 * 68 * 4;
    v4u ra[3], rb[3];
#define CMB_LOAD(R, c) do { R[0] = *(const v4u*)(phg + (size_t)(c) * 4096 + pg); R[1] = *(const v4u*)(lbase + (size_t)(c) * 4096 + lg0); R[2] = *(const v4u*)(lbase + (size_t)(c) * 4096 + lg1); } while (0)
#define CMB_WRITE(R, so) do { LAS unsigned char* sb_ = F.lds + (so); *(LAS v4u*)(sb_ + pl_) = R[0]; *(LAS v4u*)(sb_ + ll0) = R[1]; *(LAS v4u*)(sb_ + ll1) = R[2]; } while (0)
#define CMB_BAR() do { asm volatile("s_waitcnt lgkmcnt(0)" ::: "memory"); __builtin_amdgcn_s_barrier(); asm volatile("" ::: "memory"); } while (0)
    f32x4 Sacc[4];
    {   const float* l0 = lbase + (size_t)(16 * (w & 3) + v) * 64 + 4 * gq;
#pragma unroll
        for (int T = 0; T < 4; ++T) Sacc[T] = *(const f32x4*)(l0 + 16 * T); }
    CMB_LOAD(ra, 1); CMB_WRITE(ra, SLOT); CMB_LOAD(ra, 2); CMB_WRITE(ra, 2 * SLOT);
    CMB_LOAD(ra, 3); CMB_LOAD(rb, 4);
    __syncthreads();
    int s_cur = SLOT, s_nxt = 2 * SLOT, s_fre = 0;
#pragma unroll 1
    for (int c = 1; c < 127; ++c) {
        if (w < 4) {
            const LAS unsigned char* sb = F.lds + s_cur;
            f32x4 acc[4]; bf16x8 bh[2], bl[2], ah[4][2];
#pragma unroll
            for (int T = 0; T < 4; ++T) acc[T] = *(const LAS f32x4*)(sb + OFF_L + ((16 * w + v) * 68 + 16 * T + 4 * gq) * 4);
#pragma unroll
            for (int T = 0; T < 4; ++T)
#pragma unroll
                for (int s = 0; s < 2; ++s) ah[T][s] = *(const LAS bf16x8*)(sb + ((16 * T + v) * 72 + 32 * s + 8 * gq) * 2);
#pragma unroll
            for (int s = 0; s < 2; ++s) { v4u hw, lw;
#pragma unroll
                for (int p = 0; p < 4; ++p) { const float x0 = Sacc[2 * s + (p >> 1)][2 * (p & 1)], x1 = Sacc[2 * s + (p >> 1)][2 * (p & 1) + 1];
                    const unsigned hp = pg8::cvt_pk_bf16(x0, x1);
                    const float l0 = x0 - __builtin_bit_cast(float, hp << 16), l1 = x1 - __builtin_bit_cast(float, hp & 0xffff0000u);
                    hw[p] = hp; lw[p] = pg8::cvt_pk_bf16(l0, l1); }
                bh[s] = as_frag(hw); bl[s] = as_frag(lw); }
#pragma unroll
            for (int s = 0; s < 2; ++s) {
#pragma unroll
                for (int T = 0; T < 4; ++T) acc[T] = MFMA16(ah[T][s], bh[s], acc[T]);
#pragma unroll
                for (int T = 0; T < 4; ++T) acc[T] = MFMA16(ah[T][s], bl[s], acc[T]); }
            float* so = lbase + (size_t)c * 4096 + (size_t)(16 * w + v) * 64 + 4 * gq;
#pragma unroll
            for (int T = 0; T < 4; ++T) { Sacc[T] = acc[T]; *(f32x4*)(so + 16 * T) = acc[T]; }
        }
        if (c + 2 < 127) CMB_WRITE(ra, s_fre);
#pragma unroll
        for (int i = 0; i < 3; ++i) ra[i] = rb[i];
        if (c + 4 < 127) CMB_LOAD(rb, c + 4);
        CMB_BAR();
        { const int t_ = s_cur; s_cur = s_nxt; s_nxt = s_fre; s_fre = t_; }
    }
#undef CMB_LOAD
#undef CMB_WRITE
#undef CMB_BAR
}

__global__ void __launch_bounds__(NWAVES * 64, 2) fwd_kernel(Params p) {
    extern __shared__ __attribute__((aligned(16))) unsigned char lds_raw[];
    Frame F;
    F.lds = (LAS unsigned char*)lds_raw; F.wave = __builtin_amdgcn_readfirstlane((int)threadIdx.x >> 6);
    F.G = gridDim.x; F.bid = blockIdx.x;
    volatile LAS unsigned* MISC = (volatile LAS unsigned*)(F.lds + MISC_OFF);
    if ((F.wave * 64 + lane_id_asm()) < 128) MISC[(F.wave * 64 + lane_id_asm())] = 0u;
    __syncthreads();
    XcdBarrier bar = xcd_barrier_post((unsigned*)(ws_ptr() + WS_CTL) + CW_BAR, MISC + 8, F.wave);
    if ((int)ka_tab()[38]) cg::this_grid().sync();
#define ws ws_ptr()
    LAS float* wl = (LAS float*)(F.lds + F.wave * WSZ);

    p0_prologue(F);
    xcd_barrier(bar, F.wave);

#ifndef NO_P1
    for (int rep_ = 0; rep_ < (REPEAT_PHASE == 1 ? 2 : 1); ++rep_)
    {   SEpiBf16 ES{(bf16*)(ws + WS_PROJ) + (size_t)MPROMPT * PC, PC};
        sgemm_block(F, (const bf16*)(ws + WS_XN) + (size_t)MPROMPT * 1024, 1024, (const bf16*)(ws + WS_WIN), 1024, 4, 96, ES);
        SEpiBf16 EM{(bf16*)(ws + WS_KVB), 1024};
        sgemm_block(F, (const bf16*)(ws + WS_XN) + (size_t)MP * 1024, 1024, (const bf16*)(ws + WS_WIN) + (size_t)6144 * 1024, 1024, 16, 32, EM);
        pg8::Gemm g{(const pg8::bf16_t*)(ws + WS_XN), (const pg8::bf16_t*)(ws + WS_WIN), MPROMPT, PC, 1024};
        pg8::StaticOrder S; S.init(MPROMPT, PC, F.G, (int)blockIdx.x);
        EpiP1 E{(pg8::bf16_t*)(ws + WS_PROJ), (pg8::bf16_t*)(ws + WS_KVB)};
        pg8::gemm_phase<EpiP1, pg8::StaticOrder, true, true>(F.lds, g, S, E, F.wave);
    xcd_barrier(bar, F.wave);
    }
#endif
    float* lbuf = out_ptr(); bf16* pth = (bf16*)(out_ptr() + (size_t)2048 * 4096); bf16* ptl = pth + (size_t)2048 * 4096;
    for (int rep_ = 0; rep_ < (REPEAT_PHASE == 2 ? 2 : 1); ++rep_) {
    if (F.bid >= F.G - 2) { for (int i = 0; i < 4; ++i) { const int pr = 4 * (F.bid - (F.G - 2)) + i; mem_prep(F, pr >> 2, pr & 3); } __syncthreads(); }
    for (int t = F.bid * NWAVES + F.wave; t < 2032; t += F.G * NWAVES) {
        const int chain = t / 127, c = t - chain * 127; const size_t slot = (size_t)(chain * 128 + c) * 4096;
        rwkv_task<1>(F, wl, chain & 7, (chain >> 3) * TSEQ + 64 * c, 64 * c, 4, lbuf + slot, pth + slot, ptl + slot, nullptr, 0, 4); }
    xcd_barrier(bar, F.wave);
    }
    for (int rep_ = 0; rep_ < (REPEAT_PHASE == 3 ? 2 : 1); ++rep_) {
    if (F.bid < 16 && rep_ == 0) { rwkv_combine(F, F.bid); __syncthreads(); }
    {
        unsigned* qctr = (unsigned*)(ws + WS_QUEUE) + 128 * rep_;
        for (;;) {
            if (F.wave == 0 && lane_id_asm() == 0) MISC[16] = __hip_atomic_fetch_add(qctr, 1u, __ATOMIC_RELAXED, __HIP_MEMORY_SCOPE_AGENT);
            __syncthreads();
            const int u = (int)MISC[16];
            __syncthreads();
            if (u >= 512) break;
            const int uu = u >> 1, rem = uu & 127;
            if (u & 1) swa_unit(F, uu >> 7, rem & 1, rem >> 1); else mem_unit(F, uu >> 7, rem & 3, rem >> 2);
        }
        for (;;) {
            unsigned tq = 0u; if (lane_id_asm() == 0) tq = __hip_atomic_fetch_add(qctr + 64, 1u, __ATOMIC_RELAXED, __HIP_MEMORY_SCOPE_AGENT);
            const int t = __builtin_amdgcn_readfirstlane((int)tq);
            if (t >= 1282 + NLATE / 4) break;
            if (t < 256) { rwkv_task<0>(F, wl, (t >> 2) & 7, MPROMPT + 16 * (t >> 5), 0, 1, nullptr, nullptr, nullptr, nullptr, t & 3, (t & 3) + 1); }
            else if (t < 768) { const int i = t - 256; mem_sample_task(F, wl, i >> 2, i & 3); }
            else if (t < 1024) { const int i = t - 768; swa_sample_task(F, wl, i >> 1, i & 1); }
            else if (t < 1152) swa_copy_task(t - 1024);
            else if (t >= 1282) { for (int i = 0; i < 4; ++i) tr_late(4 * (t - 1282) + i, wl); }
            else {
                const int rr = t - 1152; const size_t m = rr < 2 ? (size_t)rr * TSEQ + TSEQ - 1 : (size_t)MPROMPT + (rr - 2);
                float* o = rr < 2 ? out_ptr() + O_ZP + (size_t)rr * ZC : out_ptr() + O_ZS + (size_t)(rr - 2) * ZC; const bf16* zr = (const bf16*)(ws + WS_PROJ) + m * PC;
                int l0 = lane_id_asm(); asm volatile("" : "+v"(l0));
#pragma unroll 1
                for (int c = l0; c < ZC; c += 64) o[c] = bf2f(zr[c]); }
        }
    }
    xcd_barrier(bar, F.wave);
    }
#ifndef NO_RW
    for (int rep_ = 0; rep_ < (REPEAT_PHASE == 4 ? 2 : 1); ++rep_)
    for (int t = F.bid * NWAVES + F.wave; t < 2048; t += F.G * NWAVES) { const int chain = t >> 7, c = t & 127;
        rwkv_task<2>(F, wl, chain & 7, (chain >> 3) * TSEQ + 64 * c, 64 * c, 4, c ? lbuf + (size_t)(chain * 128 + c - 1) * 4096 : nullptr, nullptr, nullptr, c == 127 ? out_ptr() + O_SP + (size_t)chain * 4096 : nullptr, 0, 4); }
#endif
    xcd_barrier(bar, F.wave);
#ifndef NO_P5
    for (int rep_ = 0; rep_ < (REPEAT_PHASE == 5 ? 2 : 1); ++rep_)
    {
        pg8::StaticOrder S; S.init(MPROMPT, 1024, F.G, (int)blockIdx.x);
        pg8::bf16_t* gate = (pg8::bf16_t*)(ws + WS_GATE); float* macc = (float*)(ws + WS_MACC); pg8::bf16_t* mrg = (pg8::bf16_t*)(ws + WS_MRG);
        const pg8::bf16_t* xn = (const pg8::bf16_t*)(ws + WS_XN); const pg8::bf16_t* win = (const pg8::bf16_t*)(ws + WS_WIN);
        const size_t so = (size_t)MPROMPT * 1024;
        EpiGate EG{gate}; SEpiGate SG{gate + so};
        { sgemm_block(F, xn + so, 1024, win + (size_t)3072 * 1024, 1024, 4, 32, SG);
          SEpiBr<0> SE{gate + so, macc + so, mrg + so}; sgemm_block(F, (const bf16*)(ws + WS_OA) + (size_t)MPROMPT * 512, 512, (const bf16*)(ws + WS_WBA), 512, 4, 32, SE); }
        { pg8::Gemm g{xn, win + (size_t)3072 * 1024, MPROMPT, 1024, 1024}; pg8::gemm_phase<EpiGate, pg8::StaticOrder, true, true>(F.lds, g, S, EG, F.wave); }
        { pg8::Gemm g{(const pg8::bf16_t*)(ws + WS_OA), (const pg8::bf16_t*)(ws + WS_WBA), MPROMPT, 1024, 512}; EpiBr<0> E{gate, macc, mrg}; pg8::gemm_phase<EpiBr<0>, pg8::StaticOrder, true, true>(F.lds, g, S, E, F.wave); }
        { sgemm_block(F, xn + so, 1024, win + (size_t)4096 * 1024, 1024, 4, 32, SG);
          SEpiBr<1> SE{gate + so, macc + so, mrg + so}; sgemm_block(F, (const bf16*)(ws + WS_OB) + (size_t)MPROMPT * 512, 512, (const bf16*)(ws + WS_WBB), 512, 4, 32, SE); }
        { pg8::Gemm g{xn, win + (size_t)4096 * 1024, MPROMPT, 1024, 1024}; pg8::gemm_phase<EpiGate, pg8::StaticOrder, true, true>(F.lds, g, S, EG, F.wave); }
        { pg8::Gemm g{(const pg8::bf16_t*)(ws + WS_OB), (const pg8::bf16_t*)(ws + WS_WBB), MPROMPT, 1024, 512}; EpiBr<1> E{gate, macc, mrg}; pg8::gemm_phase<EpiBr<1>, pg8::StaticOrder, true, true>(F.lds, g, S, E, F.wave); }
        { sgemm_block(F, xn + so, 1024, win + (size_t)5120 * 1024, 1024, 4, 32, SG);
          SEpiBr<2> SE{gate + so, macc + so, mrg + so}; sgemm_block(F, (const bf16*)(ws + WS_OC) + (size_t)MPROMPT * 512, 512, (const bf16*)(ws + WS_WBC), 512, 4, 32, SE); }
        { pg8::Gemm g{xn, win + (size_t)5120 * 1024, MPROMPT, 1024, 1024}; pg8::gemm_phase<EpiGate, pg8::StaticOrder, true, true>(F.lds, g, S, EG, F.wave); }
        { pg8::Gemm g{(const pg8::bf16_t*)(ws + WS_OC), (const pg8::bf16_t*)(ws + WS_WBC), MPROMPT, 1024, 512}; EpiBr<2> E{gate, macc, mrg}; pg8::gemm_phase<EpiBr<2>, pg8::StaticOrder, true, true>(F.lds, g, S, E, F.wave); }
    }
    xcd_barrier(bar, F.wave);
#endif
#ifndef NO_P6
    {   SEpiOut SE{in_ptr(I_XS), out_ptr() + (size_t)MPROMPT * 1024, (bf16*)(ws + WS_XN) + (size_t)MPROMPT * 1024, (float*)(ws + WS_SQS)};
        sgemm_block(F, (const bf16*)(ws + WS_MRG) + (size_t)MPROMPT * 1024, 1024, (const bf16*)(ws + WS_WOUT), 1024, 4, 32, SE);
        pg8::StaticOrder S; S.init(MPROMPT, 1024, F.G, (int)blockIdx.x);
        pg8::Gemm g{(const pg8::bf16_t*)(ws + WS_MRG), (const pg8::bf16_t*)(ws + WS_WOUT), MPROMPT, 1024, 1024};
        EpiOut E{in_ptr(I_XP), in_ptr(I_XS), out_ptr(), (pg8::bf16_t*)(ws + WS_XN), (float*)(ws + WS_SQ)};
        pg8::gemm_phase<EpiOut, pg8::StaticOrder, true, true>(F.lds, g, S, E, F.wave);
    }
    xcd_barrier(bar, F.wave);
#endif
#ifndef NO_P7
    for (int rep_ = 0; rep_ < (REPEAT_PHASE == 7 ? 2 : 1); ++rep_)
    {   SEpiUp SE{(const float*)(ws + WS_SQS), (bf16*)(ws + WS_H) + (size_t)MPROMPT * 4096};
        sgemm_block(F, (const bf16*)(ws + WS_XN) + (size_t)MPROMPT * 1024, 1024, (const bf16*)(ws + WS_WUP), 1024, 4, 128, SE);
        pg8::StaticOrder S; S.init(MPROMPT, 4096, F.G, (int)blockIdx.x);
        pg8::Gemm g{(const pg8::bf16_t*)(ws + WS_XN), (const pg8::bf16_t*)(ws + WS_WUP), MPROMPT, 4096, 1024};
        EpiUp E{(const float*)(ws + WS_SQ), (pg8::bf16_t*)(ws + WS_H)};
        pg8::gemm_phase<EpiUp, pg8::StaticOrder, true, true>(F.lds, g, S, E, F.wave);
    }
    xcd_barrier(bar, F.wave);
#endif
#ifndef NO_P8
    {   SEpiDown SE{out_ptr() + (size_t)MPROMPT * 1024};
        sgemm_block(F, (const bf16*)(ws + WS_H) + (size_t)MPROMPT * 4096, 4096, (const bf16*)(ws + WS_WDN), 4096, 4, 32, SE);
        pg8::StaticOrder S; S.init(MPROMPT, 1024, F.G, (int)blockIdx.x);
        pg8::Gemm g{(const pg8::bf16_t*)(ws + WS_H), (const pg8::bf16_t*)(ws + WS_WDN), MPROMPT, 1024, 4096};
        EpiDown E{out_ptr()};
        pg8::gemm_phase<EpiDown, pg8::StaticOrder, true, true>(F.lds, g, S, E, F.wave);
    }
#endif
}

#undef ws
extern "C" void kernel_launch(void* const* d_in, const int* in_sizes, int n_in, void* d_out, int out_size, void* d_ws, size_t ws_size, hipStream_t stream) {
    static int grid = 0;
    if (grid == 0) {
        if (n_in != 36 || ws_size < WS_END) { fprintf(stderr, "kernel_launch: unexpected n_in %d / ws %zu\n", n_in, ws_size); grid = -1; return; }
        int dev = 0, cus = 0, per_cu = 0;
        if (hipGetDevice(&dev) != hipSuccess || hipDeviceGetAttribute(&cus, hipDeviceAttributeMultiprocessorCount, dev) != hipSuccess) { grid = -1; return; }
        if (hipFuncSetAttribute((const void*)fwd_kernel, hipFuncAttributeMaxDynamicSharedMemorySize, LDS_BYTES) != hipSuccess) { fprintf(stderr, "kernel_launch: hipFuncSetAttribute failed\n"); grid = -1; return; }
        if (hipOccupancyMaxActiveBlocksPerMultiprocessor(&per_cu, (const void*)fwd_kernel, NWAVES * 64, LDS_BYTES) != hipSuccess || per_cu < 1) { fprintf(stderr, "kernel_launch: occupancy query says %d\n", per_cu); per_cu = 1; }
        (void)hipGetLastError();
        grid = cus;
    }
    if (grid < 0) return;
    if (hipMemsetAsync((char*)d_ws + WS_CTL, 0, CTL_ZERO_BYTES, stream) != hipSuccess) { fprintf(stderr, "kernel_launch: memset failed\n"); return; }
    Params a{};
    for (int i = 0; i < 36; ++i) a.in[i] = (const float*)d_in[i];
    a.out = (float*)d_out; a.ws = (unsigned char*)d_ws; a.never = 0; a.pad = 0;
    void* args[] = {&a};
    hipError_t e = hipLaunchCooperativeKernel((const void*)fwd_kernel, dim3(grid), dim3(NWAVES * 64), args, LDS_BYTES, stream);
    if (e != hipSuccess) fprintf(stderr, "kernel_launch: cooperative launch failed: %s (grid %d)\n", hipGetErrorString(e), grid);
}
```

```cpp
#include <hip/hip_runtime.h>
#include <hip/hip_cooperative_groups.h>
#include <cstdio>
#include <cstdint>
namespace cg = cooperative_groups;
#ifndef REPEAT_PHASE
#define REPEAT_PHASE 0
#endif
__device__ __forceinline__ int lane_id_asm() { int l; asm volatile("v_mbcnt_lo_u32_b32 %0, -1, 0\n\tv_mbcnt_hi_u32_b32 %0, -1, %0" : "=v"(l)); return l; }
namespace pg8 {
#define PG8_LAS __attribute__((address_space(3)))
typedef unsigned short bf16_t;
typedef short bf16x8 __attribute__((ext_vector_type(8)));
typedef float f32x4 __attribute__((ext_vector_type(4)));
typedef unsigned u32x4 __attribute__((ext_vector_type(4)));
constexpr int BM = 256, BK = 64, HALF = 128, HTB = HALF * BK * 2  , STAGE_BYTES = 8 * HTB, NXCD = 8, WGM = 8;

__host__ __device__ __forceinline__ int lds_byte(int r, int c) { const int st = (r >> 4) * 2 + (c >> 5), rr = r & 15, cc = c & 31, ob = rr * 64 + cc * 2; return st * 1024 + (ob ^ (((ob >> 9) & 1) << 5)); }
__host__ __device__ __forceinline__ void stage_rc(int b, int& R, int& C) { const int st = b / 1024, sb = b % 1024, swz = sb ^ (((sb >> 9) & 1) << 5); R = (st >> 1) * 16 + swz / 64; C = (st & 1) * 32 + (swz % 64) / 2; }
__host__ __device__ __forceinline__ int perm32(int rho) { const int n = rho >> 4, i = rho & 15; return 8 * (i >> 2) + 4 * n + (i & 3); }

struct Unit { int pm, pn; };
struct Gemm { const bf16_t* A; const bf16_t* Bt; int M, N, K; };

struct StaticOrder {
    int nM, nN, nwg, G, c;
    __host__ __device__ void init(int M, int N, int G_, int c_) { nM = M / BM; nN = N / BM; nwg = nM * nN; G = G_; c = c_; }
    __host__ __device__ bool next(int i, Unit& u) const {
        const long L = (long)i * G + c; if (L >= nwg) return false;
        int wgid = (int)L; { const int q = nwg / NXCD, r = nwg % NXCD, xcd = wgid % NXCD, off = wgid / NXCD; wgid = (xcd < r ? xcd * (q + 1) : r * (q + 1) + (xcd - r) * q) + off; }
        const int nig = WGM * nN, gid = wgid / nig, fm = gid * WGM, gsz = (nM - fm) < WGM ? (nM - fm) : WGM;
        u.pm = fm + ((wgid % nig) % gsz); u.pn = (wgid % nig) / gsz; return true;
    }
    __device__ __forceinline__ void a_ready(const Unit&) const {}
    __device__ __forceinline__ void done(const Unit&) const {}
};

__device__ __forceinline__ unsigned cvt_pk_bf16(float lo, float hi) { unsigned r; asm volatile("v_cvt_pk_bf16_f32 %0, %1, %2" : "=v"(r) : "v"(lo), "v"(hi)); return r; }
typedef float f32x2 __attribute__((ext_vector_type(2)));
template <class Epi, class Sched, bool ALIGN_EPI = false, bool SP2 = false>
__device__ __forceinline__ void gemm_phase(PG8_LAS unsigned char* lds, const Gemm g, const Sched& S, const Epi& E, int wave_id) {
    const int tid_l = wave_id * 64 + lane_id_asm();
    const int tid = tid_l, wid = __builtin_amdgcn_readfirstlane(tid >> 6), lane = tid & 63, wr = wid >> 2, wc = wid & 3, fr = lane & 15, fq = lane >> 4;
    const int K = g.K, nt = K / BK;
    unsigned voffA[2], voffB[2];
#pragma unroll
    for (int i = 0; i < 2; ++i) { int R, C; stage_rc(tid * 16 + i * 8192, R, C); const int Rb = Epi::PERM ? ((R & ~31) + perm32(R & 31)) : R;
        voffA[i] = (unsigned)(R * K + C) * 2u; voffB[i] = (unsigned)(Rb * K + C) * 2u; }
    const size_t kstep = (size_t)(BK * 2);
    const size_t hstep = (size_t)HALF * K * 2;
    const size_t tstep = 2 * hstep;
    const unsigned ldsw = (unsigned)wid * 1024u;
    const int aoff = lds_byte(wr * 64 + fr, fq * 8), boff = lds_byte(wc * 32 + fr, fq * 8);
#define PG8_SA(b, h) (((b) * 2 + (h)) * HTB)
#define PG8_SB(b, h) ((4 + (b) * 2 + (h)) * HTB)
#define PG8_STAGE(bufoff, gbase, voff) do { _Pragma("unroll") for (int _i = 0; _i < 2; ++_i) \
        __builtin_amdgcn_global_load_lds((const unsigned*)((const char*)(gbase) + (voff)[_i]), (PG8_LAS unsigned*)(lds + (bufoff) + ldsw + _i * 8192), 16, 0, 0); } while (0)
#define PG8_LDA(dst, b, h) do { _Pragma("unroll") for (int m = 0; m < 4; ++m) _Pragma("unroll") for (int k = 0; k < 2; ++k) dst[m][k] = *(const PG8_LAS bf16x8*)(lds + PG8_SA(b, h) + aoff + m * 2048 + k * 1024); } while (0)
#define PG8_LDB(dst, b, h) do { _Pragma("unroll") for (int n = 0; n < 2; ++n) _Pragma("unroll") for (int k = 0; k < 2; ++k) dst[n][k] = *(const PG8_LAS bf16x8*)(lds + PG8_SB(b, h) + boff + n * 2048 + k * 1024); } while (0)
#define PG8_MMA(ai, bj, At, Bt) do { __builtin_amdgcn_s_setprio(1); _Pragma("unroll") for (int m = 0; m < 4; ++m) _Pragma("unroll") for (int n = 0; n < 2; ++n) _Pragma("unroll") for (int k = 0; k < 2; ++k) \
        acc[ai][bj][m][n] = __builtin_amdgcn_mfma_f32_16x16x32_bf16(Bt[n][k], At[m][k], acc[ai][bj][m][n], 0, 0, 0); __builtin_amdgcn_s_setprio(0); } while (0)
#define PG8_WAIT_V(n) asm volatile("s_waitcnt vmcnt(" #n ")" ::: "memory")
#define PG8_WAIT_L(n) asm volatile("s_waitcnt lgkmcnt(" #n ")" ::: "memory")
#define PG8_BAR __builtin_amdgcn_s_barrier()
#define PG8_SCHED __builtin_amdgcn_sched_barrier(0)
    Unit cur, nxt; int ui = 0;
    if (!S.next(0, cur)) return;
    f32x4 acc[2][2][4][2];
#pragma unroll
    for (int a = 0; a < 2; ++a)
#pragma unroll
        for (int b = 0; b < 2; ++b)
#pragma unroll
            for (int m = 0; m < 4; ++m)
#pragma unroll
                for (int n = 0; n < 2; ++n) acc[a][b][m][n] = (f32x4){0.f, 0.f, 0.f, 0.f};
    bf16x8 At[4][2], B0[2][2], B1[2][2];
    const char* cA = (const char*)g.A + (size_t)cur.pm * tstep; const char* cB = (const char*)g.Bt + (size_t)cur.pn * tstep;
    S.a_ready(cur);
    if constexpr (SP2) {
        PG8_STAGE(PG8_SB(0, 0), cB, voffB); PG8_STAGE(PG8_SB(0, 1), cB + hstep, voffB); PG8_STAGE(PG8_SA(0, 0), cA, voffA); PG8_STAGE(PG8_SA(0, 1), cA + hstep, voffA);
        if (wr == 1) PG8_BAR;
        PG8_WAIT_V(2); PG8_BAR;
        PG8_STAGE(PG8_SB(1, 0), cB + kstep, voffB); PG8_STAGE(PG8_SA(1, 0), cA + kstep, voffA); PG8_STAGE(PG8_SB(1, 1), cB + hstep + kstep, voffB);
        PG8_WAIT_V(6); PG8_BAR;
    } else {
        PG8_STAGE(PG8_SB(0, 0), cB, voffB); PG8_STAGE(PG8_SA(0, 0), cA, voffA); PG8_STAGE(PG8_SB(0, 1), cB + hstep, voffB); PG8_STAGE(PG8_SA(0, 1), cA + hstep, voffA);
        if (wr == 1) PG8_BAR;
        PG8_WAIT_V(4); PG8_BAR;
        PG8_STAGE(PG8_SB(1, 0), cB + kstep, voffB); PG8_STAGE(PG8_SA(1, 0), cA + kstep, voffA); PG8_STAGE(PG8_SB(1, 1), cB + hstep + kstep, voffB);
        PG8_WAIT_V(6); PG8_BAR;
    }
    for (;;) {
        const bool has_next = S.next(ui + 1, nxt);
        const char* nA = has_next ? (const char*)g.A + (size_t)nxt.pm * tstep : cA; const char* nB = has_next ? (const char*)g.Bt + (size_t)nxt.pn * tstep : cB;
        for (int t = 0; t < nt; t += 2) {
            const bool last = (t == nt - 2);
            const char* a1 = cA + (size_t)(t + 1) * kstep;
            const char* a2 = last ? nA : cA + (size_t)(t + 2) * kstep; const char* b2 = last ? nB : cB + (size_t)(t + 2) * kstep;
            const char* a3 = a2 + kstep; const char* b3 = b2 + kstep;
            if (last && has_next) S.a_ready(nxt);
            if constexpr (SP2) {
            PG8_LDB(B0, 0, 0); PG8_LDB(B1, 0, 1); PG8_SCHED; PG8_LDA(At, 0, 0); PG8_STAGE(PG8_SA(1, 1), a1 + hstep, voffA);
            PG8_WAIT_V(8); PG8_WAIT_L(0); PG8_BAR; PG8_MMA(0, 0, At, B0); PG8_MMA(0, 1, At, B1); PG8_BAR; PG8_SCHED;
            PG8_LDA(At, 0, 1); PG8_STAGE(PG8_SB(0, 0), b2, voffB); PG8_STAGE(PG8_SB(0, 1), b2 + hstep, voffB); PG8_STAGE(PG8_SA(0, 0), a2, voffA);
            PG8_WAIT_V(8); PG8_WAIT_L(0); PG8_BAR; PG8_MMA(1, 0, At, B0); PG8_MMA(1, 1, At, B1); PG8_BAR; PG8_SCHED;
            PG8_LDB(B0, 1, 0); PG8_LDB(B1, 1, 1); PG8_SCHED; PG8_LDA(At, 1, 0); PG8_STAGE(PG8_SA(0, 1), a2 + hstep, voffA);
            PG8_WAIT_V(8); PG8_WAIT_L(0); PG8_BAR; PG8_MMA(0, 0, At, B0); PG8_MMA(0, 1, At, B1); PG8_BAR; PG8_SCHED;
            PG8_LDA(At, 1, 1); PG8_STAGE(PG8_SB(1, 0), b3, voffB); PG8_STAGE(PG8_SB(1, 1), b3 + hstep, voffB); PG8_STAGE(PG8_SA(1, 0), a3, voffA);
            PG8_WAIT_V(8); PG8_WAIT_L(0); PG8_BAR; PG8_MMA(1, 0, At, B0); PG8_MMA(1, 1, At, B1); PG8_BAR; PG8_SCHED;
            } else {
            PG8_LDB(B0, 0, 0); PG8_SCHED; PG8_LDA(At, 0, 0); PG8_STAGE(PG8_SA(1, 1), a1 + hstep, voffA);
            PG8_WAIT_L(8); PG8_BAR; PG8_WAIT_L(0); PG8_MMA(0, 0, At, B0); PG8_BAR; PG8_SCHED;
            PG8_LDB(B1, 0, 1); PG8_STAGE(PG8_SB(0, 0), b2, voffB);
            PG8_BAR; PG8_WAIT_L(0); PG8_MMA(0, 1, At, B1); PG8_BAR;
            PG8_LDA(At, 0, 1); PG8_STAGE(PG8_SA(0, 0), a2, voffA);
            PG8_BAR; PG8_WAIT_L(0); PG8_MMA(1, 0, At, B0); PG8_BAR; PG8_SCHED;
            PG8_STAGE(PG8_SB(0, 1), b2 + hstep, voffB);
            PG8_WAIT_V(6); PG8_BAR; PG8_MMA(1, 1, At, B1); PG8_BAR;
            PG8_LDB(B0, 1, 0); PG8_SCHED; PG8_LDA(At, 1, 0); PG8_STAGE(PG8_SA(0, 1), a2 + hstep, voffA);
            PG8_WAIT_L(8); PG8_BAR; PG8_WAIT_L(0); PG8_MMA(0, 0, At, B0); PG8_BAR; PG8_SCHED;
            PG8_LDB(B1, 1, 1); PG8_STAGE(PG8_SB(1, 0), b3, voffB);
            PG8_BAR; PG8_WAIT_L(0); PG8_MMA(0, 1, At, B1); PG8_BAR;
            PG8_LDA(At, 1, 1); PG8_STAGE(PG8_SA(1, 0), a3, voffA);
            PG8_BAR; PG8_WAIT_L(0); PG8_MMA(1, 0, At, B0); PG8_BAR; PG8_SCHED;
            PG8_STAGE(PG8_SB(1, 1), b3 + hstep, voffB);
            PG8_WAIT_V(6); PG8_BAR; PG8_MMA(1, 1, At, B1); PG8_BAR;
            }
        }
        if constexpr (ALIGN_EPI) { if (wr == 0) PG8_BAR; }
        if constexpr (!Epi::AFTER_DRAIN) { E(acc, cur, wr, wc, fr, fq); S.done(cur); }
        if (!has_next) break;
#pragma unroll
        for (int a = 0; a < 2; ++a)
#pragma unroll
            for (int b = 0; b < 2; ++b)
#pragma unroll
                for (int m = 0; m < 4; ++m)
#pragma unroll
                    for (int n = 0; n < 2; ++n) acc[a][b][m][n] = (f32x4){0.f, 0.f, 0.f, 0.f};
        cur = nxt; cA = nA; cB = nB; ++ui;
        if constexpr (ALIGN_EPI) { if (wr == 1) PG8_BAR; }
    }
    PG8_WAIT_V(0);
    if constexpr (!ALIGN_EPI) { if (wr == 0) PG8_BAR; }
    PG8_BAR;
    if constexpr (Epi::AFTER_DRAIN) { E.fused(acc, cur, wr, wc, fr, fq, lds, wid, lane); S.done(cur); }
#undef PG8_SA
#undef PG8_SB
#undef PG8_STAGE
#undef PG8_LDA
#undef PG8_LDB
#undef PG8_MMA
#undef PG8_WAIT_V
#undef PG8_WAIT_L
#undef PG8_BAR
#undef PG8_SCHED
}
}
#define GAS __attribute__((address_space(1)))
#define LAS __attribute__((address_space(3)))
typedef unsigned short bf16;
typedef unsigned v4u __attribute__((ext_vector_type(4)));
typedef float f32x4 __attribute__((ext_vector_type(4)));
typedef short bf16x8 __attribute__((ext_vector_type(8)));
typedef GAS unsigned gu32;
typedef GAS unsigned long long gu64;
#define RLX_AGENT __ATOMIC_RELAXED, __HIP_MEMORY_SCOPE_AGENT
#define LDS_WAIT() asm volatile("s_waitcnt lgkmcnt(0)" ::: "memory")
#define VM_WAIT() asm volatile("s_waitcnt vmcnt(0)" ::: "memory")
__device__ __forceinline__ unsigned long long rt() { return __builtin_amdgcn_s_memrealtime(); }
__device__ __forceinline__ unsigned f2bf(float f) { unsigned u = __builtin_bit_cast(unsigned, f); return (u + 0x7fffu + ((u >> 16) & 1u)) >> 16; }
__device__ __forceinline__ unsigned pk2(float lo, float hi) { return f2bf(lo) | (f2bf(hi) << 16); }

#define XB_TMO      128
#define XB_XCNT(j)  (256  + 64 * (j))
#define XB_XSUB(j)  (1280 + 64 * (j))
#define XB_XGEN(j)  (2304 + 64 * (j))
#define XB_TOP      3328
#define XB_TOPGEN   3392
#define XCD_BAR_WORDS 3456
#define XB_SPIN_CAP (1u << 18)

__device__ __forceinline__ unsigned xb_ld(unsigned* p)              { return __hip_atomic_load(p, __ATOMIC_RELAXED, __HIP_MEMORY_SCOPE_AGENT); }
__device__ __forceinline__ unsigned xb_add(unsigned* p, unsigned v) { return __hip_atomic_fetch_add(p, v, __ATOMIC_RELAXED, __HIP_MEMORY_SCOPE_AGENT); }
__device__ __forceinline__ unsigned xb_xcc_id() { return (unsigned)__builtin_amdgcn_s_getreg((3 << 11) | 20) & 0xFu; }
#define XB_SPIN(cond, bar) do { unsigned _sp = 0; while (cond) { __builtin_amdgcn_s_sleep(1); \
    if ((++_sp & 255u) == 0u) { if (xb_ld(&(bar)[XB_TMO])) break; if (_sp > XB_SPIN_CAP) { atomicAdd(&(bar)[XB_TMO], 1u); break; } } } } while (0)

struct XcdBarrier {
    unsigned* bar; unsigned x;
    volatile LAS unsigned* st;
};

__device__ __forceinline__ XcdBarrier xcd_barrier_post(unsigned* bar, volatile LAS unsigned* st, int bwave) {
    XcdBarrier b; b.bar = bar; b.x = xb_xcc_id(); b.st = st;
    if (bwave == 0 && lane_id_asm() == 0) (void)xb_add(&bar[XB_XCNT(b.x)], 1u);
    return b;
}
__device__ __forceinline__ void xcd_barrier_complete(unsigned* bar, unsigned x, unsigned& nloc, unsigned& nx) {
    const unsigned G = gridDim.x * gridDim.y * gridDim.z;
    unsigned sum, cnt, mine, sp = 0u;
    for (;;) {
        sum = 0u; cnt = 0u; mine = 0u;
#pragma unroll
        for (unsigned j = 0; j < 16; ++j) { const unsigned c = xb_ld(&bar[XB_XCNT(j)]); sum += c; cnt += (c > 0u) ? 1u : 0u; mine = (j == x) ? c : mine; }
        if (sum == G) break;
        __builtin_amdgcn_s_sleep(1);
        if ((++sp & 255u) == 0u) { if (xb_ld(&bar[XB_TMO])) break; if (sp > XB_SPIN_CAP) { atomicAdd(&bar[XB_TMO], 1u); break; } }
    }
    nloc = mine > 0u ? mine : 1u; nx = cnt > 0u ? cnt : 1u;
}

__device__ __forceinline__ void xcd_barrier(const XcdBarrier& b, int bwave) {
    asm volatile("s_waitcnt vmcnt(0)" ::: "memory");
    __syncthreads();
    if (bwave == 0 && lane_id_asm() == 0) {
        unsigned* bar = b.bar;
        __builtin_amdgcn_s_waitcnt(0);
        unsigned nloc = b.st[0], nx = b.st[1];
        if (nloc == 0u) { xcd_barrier_complete(bar, b.x, nloc, nx); b.st[0] = nloc; b.st[1] = nx; }
        const unsigned old = xb_add(&bar[XB_XSUB(b.x)], 1u);
        const unsigned gen = old / nloc;
        if (old + 1u == (gen + 1u) * nloc) {
            __builtin_amdgcn_fence(__ATOMIC_RELEASE, "agent");
            asm volatile("s_waitcnt vmcnt(0)" ::: "memory");
            const unsigned og = xb_add(&bar[XB_TOP], 1u);
            const unsigned tg = og / nx;
            if (og + 1u == (tg + 1u) * nx) xb_add(&bar[XB_TOPGEN], 1u);
            else XB_SPIN(xb_ld(&bar[XB_TOPGEN]) == tg, bar);
            __builtin_amdgcn_fence(__ATOMIC_ACQUIRE, "agent");
            xb_add(&bar[XB_XGEN(b.x)], 1u);
            asm volatile("s_waitcnt vmcnt(0)" ::: "memory");
        } else {
            XB_SPIN(xb_ld(&bar[XB_XGEN(b.x)]) == gen, bar);
            __builtin_amdgcn_fence(__ATOMIC_ACQUIRE, "agent");
            asm volatile("s_waitcnt vmcnt(0)" ::: "memory");
        }
    }
    __syncthreads();
}

constexpr int DM = 1024, TSEQ = 8192, MPROMPT = 16384, NSAMP = 128, MTOK = 16512, MP = 16640, MA = MP + 512;
constexpr int PC = 3072;
constexpr int C_Q = 1792, C_K = 2304, C_V = 2432, C_XQ = 2560, ZC = 1792;
constexpr int NWAVES = 8;
constexpr int LDS_BYTES = 155648, MISC_OFF = LDS_BYTES - 512, WSZ = 17920;
constexpr size_t WS_CTL = 0, CTL_ZERO_BYTES = 1u << 20;
constexpr size_t WS_WIN = 1u << 20;
constexpr size_t WS_WBA = WS_WIN + (size_t)7168 * 1024 * 2;
constexpr size_t WS_WBB = WS_WBA + (size_t)1024 * 512 * 2;
constexpr size_t WS_WBC = WS_WBB + (size_t)1024 * 512 * 2;
constexpr size_t WS_WOUT = WS_WBC + (size_t)1024 * 512 * 2;
constexpr size_t WS_WUP = WS_WOUT + (size_t)1024 * 1024 * 2;
constexpr size_t WS_WDN = WS_WUP + (size_t)4096 * 1024 * 2;
constexpr size_t WS_W2T = WS_WDN + (size_t)4096 * 1024 * 2;
constexpr size_t WS_A2T = WS_W2T + 65536;
constexpr size_t WS_G2T = WS_A2T + 65536;
constexpr size_t WS_ROPE = WS_G2T + 131072;
constexpr size_t WS_SQ = WS_ROPE + (1u << 20);
constexpr size_t WS_XN = WS_SQ + (size_t)MP * 16 * 4;
constexpr size_t WS_KVB = WS_XN + (size_t)MA * 1024 * 2;
constexpr size_t WS_MRG = WS_KVB + (size_t)512 * 1024 * 2;
constexpr size_t WS_PROJ = WS_MRG + (size_t)MP * 1024 * 2;
constexpr size_t WS_OA = WS_PROJ + (size_t)MP * PC * 2;
constexpr size_t WS_OB = WS_OA + (size_t)MP * 512 * 2;
constexpr size_t WS_OC = WS_OB + (size_t)MP * 512 * 2;
constexpr size_t WS_MKN = WS_OC + (size_t)MP * 512 * 2;
constexpr size_t WS_MVT = WS_MKN + 524288;
constexpr size_t WS_END = WS_MVT + 524288;
constexpr size_t WS_GATE = WS_PROJ;
constexpr size_t WS_MACC = WS_PROJ + (size_t)MP * 1024 * 2;
constexpr size_t WS_H = WS_PROJ;
static_assert(WS_H + (size_t)MP * 4096 * 2 <= WS_MKN, "h overlay");
static_assert(WS_END <= 268435456, "d_ws map");
constexpr int CW_BAR = 4096;
constexpr size_t WS_QUEUE = 589824;
constexpr size_t WS_SQS = 524288;
constexpr size_t O_YP = 0, O_SP = 16908288, O_ZP = 16973824, O_KP = 16977408, O_VP = 17010176, O_MKP = 17042944, O_MVP = 17305088,
                 O_SS = 17567232, O_ZS = 21761536, O_KS = 21990912, O_VS = 24088064;

struct Params { const float* in[36]; float* out; unsigned char* ws; int never; int pad; };
enum { I_XP = 0, I_XS, I_SRW, I_SHIFT, I_CK, I_CV, I_CMK, I_CMV, I_MEM, I_NMIX, I_WIN, I_MU, I_W0, I_W2, I_A0, I_A2, I_G2, I_KK, I_KA, I_RK, I_LNW, I_LNB,
       I_QN, I_KN, I_SINK, I_MEMN, I_WMKV, I_XQN, I_XKN, I_WBA, I_WBB, I_WBC, I_WOUT, I_NFFN, I_WUP, I_WDN };

typedef const __attribute__((address_space(4))) unsigned long long* katab_t;
__device__ __forceinline__ katab_t ka_tab() { katab_t tab = (katab_t)__builtin_amdgcn_kernarg_segment_ptr(); asm volatile("" : "+s"(tab)); return tab; }
__device__ __forceinline__ const float* in_ptr(int i) { return (const float*)(const GAS float*)ka_tab()[i]; }
__device__ __forceinline__ float* out_ptr() { return (float*)(GAS float*)ka_tab()[36]; }
__device__ __forceinline__ unsigned char* ws_ptr() { return (unsigned char*)(GAS unsigned char*)ka_tab()[37]; }
struct Frame {
    LAS unsigned char* lds; int wave, G, bid;
};
__device__ __forceinline__ float bf2f(unsigned short u) { return __builtin_bit_cast(float, (unsigned)u << 16); }
__device__ __forceinline__ float wave_sum(float v) {
#pragma unroll
    for (int o = 1; o < 64; o <<= 1) v += __shfl_xor(v, o);
    return v;
}
__device__ __forceinline__ float wave_max(float v) {
#pragma unroll
    for (int o = 1; o < 64; o <<= 1) v = fmaxf(v, __shfl_xor(v, o));
    return v;
}
__device__ __forceinline__ float dpp_xor1(float x) { return __builtin_bit_cast(float, __builtin_amdgcn_mov_dpp(__builtin_bit_cast(int, x), 0xB1, 0xF, 0xF, true)); }
__device__ __forceinline__ float dpp_xor2(float x) { return __builtin_bit_cast(float, __builtin_amdgcn_mov_dpp(__builtin_bit_cast(int, x), 0x4E, 0xF, 0xF, true)); }
__device__ __forceinline__ void unpack8(v4u w, float* x) {
    x[0] = __builtin_bit_cast(float, w.x << 16); x[1] = __builtin_bit_cast(float, w.x & 0xffff0000u);
    x[2] = __builtin_bit_cast(float, w.y << 16); x[3] = __builtin_bit_cast(float, w.y & 0xffff0000u);
    x[4] = __builtin_bit_cast(float, w.z << 16); x[5] = __builtin_bit_cast(float, w.z & 0xffff0000u);
    x[6] = __builtin_bit_cast(float, w.w << 16); x[7] = __builtin_bit_cast(float, w.w & 0xffff0000u);
}
__device__ __forceinline__ v4u pack8(const float* y) { v4u o; o.x = pk2(y[0], y[1]); o.y = pk2(y[2], y[3]); o.z = pk2(y[4], y[5]); o.w = pk2(y[6], y[7]); return o; }
__device__ __forceinline__ bf16x8 as_frag(v4u w) { return __builtin_bit_cast(bf16x8, w); }
#define MFMA16(a, b, c) __builtin_amdgcn_mfma_f32_16x16x32_bf16((a), (b), (c), 0, 0, 0)

__device__ __forceinline__ void tr_item(const float* W, int K, int N, bf16* WT, int row_off, LAS float* scr, int item, int lane, const float* kscale) {
    const int nblk = N / 32, kb = item / nblk, nb = item % nblk, k0 = 64 * kb, n0 = 32 * nb;
#pragma unroll
    for (int i = 0; i < 32; ++i) { const int kk = 2 * i + (lane >> 5); float v = W[(size_t)(k0 + kk) * N + n0 + (lane & 31)]; if (kscale) v *= kscale[k0 + kk]; scr[kk * 33 + (lane & 31)] = v; }
    LDS_WAIT(); asm volatile("" ::: "memory");
    const int c = lane & 7;
#pragma unroll
    for (int j = 0; j < 4; ++j) { const int n = (lane >> 3) + 8 * j; const LAS float* s = scr + (8 * c) * 33 + n;
        v4u o; o.x = pk2(s[0 * 33], s[1 * 33]); o.y = pk2(s[2 * 33], s[3 * 33]); o.z = pk2(s[4 * 33], s[5 * 33]); o.w = pk2(s[6 * 33], s[7 * 33]);
        *(GAS v4u*)(WT + (size_t)(row_off + n0 + n) * K + k0 + 8 * c) = o; }
    LDS_WAIT(); asm volatile("" ::: "memory");
}
template <int CTRL> __device__ __forceinline__ float dppq1(float x) { return __builtin_bit_cast(float, __builtin_amdgcn_mov_dpp(__builtin_bit_cast(int, x), CTRL, 0xF, 0xF, true)); }
template <int CTRL, int RM> __device__ __forceinline__ float dppz1(float x) { return __builtin_bit_cast(float, __builtin_amdgcn_update_dpp(0, __builtin_bit_cast(int, x), CTRL, RM, 0xF, false)); }
__device__ __forceinline__ float wsum1(float v) { v += dppq1<0xB1>(v); v += dppq1<0x4E>(v); v += dppq1<0x141>(v); v += dppq1<0x140>(v); v += dppz1<0x142, 0xA>(v); v += dppz1<0x143, 0xC>(v);
    return __builtin_bit_cast(float, __builtin_amdgcn_readlane(__builtin_bit_cast(int, v), 63)); }
__device__ __forceinline__ void rms_rows2_to_bf16(int lane, const float* xrow0, const float* xrow1, const float* gain0, const float* gain1, bf16* orow0, bf16* orow1) {
    const GAS f32x4* xr0 = (const GAS f32x4*)xrow0 + lane; const GAS f32x4* xr1 = (const GAS f32x4*)xrow1 + lane;
    f32x4 v0[4], v1[4]; float s0 = 0.f, s1 = 0.f;
#pragma unroll
    for (int j = 0; j < 4; ++j) { v0[j] = xr0[64 * j]; v1[j] = xr1[64 * j]; }
#pragma unroll
    for (int j = 0; j < 4; ++j) { s0 += (v0[j].x * v0[j].x + v0[j].y * v0[j].y) + (v0[j].z * v0[j].z + v0[j].w * v0[j].w); s1 += (v1[j].x * v1[j].x + v1[j].y * v1[j].y) + (v1[j].z * v1[j].z + v1[j].w * v1[j].w); }
    const float r0 = 1.f / sqrtf(wsum1(s0) * (1.f / 1024.f) + 1e-5f), r1 = 1.f / sqrtf(wsum1(s1) * (1.f / 1024.f) + 1e-5f);
    const GAS f32x4* g0 = (const GAS f32x4*)gain0 + lane; const GAS f32x4* g1 = (const GAS f32x4*)gain1 + lane;
    GAS unsigned long long* o0 = (GAS unsigned long long*)orow0 + lane; GAS unsigned long long* o1 = (GAS unsigned long long*)orow1 + lane;
#pragma unroll
    for (int j = 0; j < 4; ++j) { const f32x4 ga = g0[64 * j], gb = g1[64 * j];
        o0[64 * j] = (unsigned long long)pk2(v0[j].x * r0 * ga.x, v0[j].y * r0 * ga.y) | ((unsigned long long)pk2(v0[j].z * r0 * ga.z, v0[j].w * r0 * ga.w) << 32);
        o1[64 * j] = (unsigned long long)pk2(v1[j].x * r1 * gb.x, v1[j].y * r1 * gb.y) | ((unsigned long long)pk2(v1[j].z * r1 * gb.z, v1[j].w * r1 * gb.w) << 32); }
}
__constant__ double ROPE_INVF[8] = {1.0, 0.19392274474868576, 0.03760603093086393, 0.007292664737217109, 0.001414213562373095, 0.0002742481756762073, 5.318295896944988e-05, 1.031338537721246e-05};
__device__ __forceinline__ void p0_prologue(Frame& F) {
    LAS float* scr = (LAS float*)(F.lds + F.wave * 16384);
    const int gw = F.bid * NWAVES + F.wave, NGW = F.G * NWAVES;
    unsigned char* ws = ws_ptr();
    constexpr int E0 = 16 * 96, E1 = 16 * 32, E6 = 16, E7 = 32;
    constexpr int NEARLY = E0 + E1 + 2 * E6 + E7;
    for (int it = gw; it < NEARLY; it += NGW) {
        int r = it;
        if (r < E0) { tr_item(in_ptr(I_WIN), 1024, 6144, (bf16*)(ws + WS_WIN), 0, scr, (r / 96) * 192 + (r % 96), lane_id_asm(), nullptr); continue; } r -= E0;
        if (r < E1) { tr_item(in_ptr(I_WMKV), 1024, 1024, (bf16*)(ws + WS_WIN), 6144, scr, r, lane_id_asm(), nullptr); continue; } r -= E1;
        if (r < E6) { tr_item(in_ptr(I_W2), 64, 512, (bf16*)(ws + WS_W2T), 0, scr, r, lane_id_asm(), nullptr); continue; } r -= E6;
        if (r < E6) { tr_item(in_ptr(I_A2), 64, 512, (bf16*)(ws + WS_A2T), 0, scr, r, lane_id_asm(), nullptr); continue; } r -= E6;
        tr_item(in_ptr(I_G2), 128, 512, (bf16*)(ws + WS_G2T), 0, scr, r, lane_id_asm(), nullptr);
    }
    bf16* XN = (bf16*)(ws + WS_XN);
    {   const float* xp = in_ptr(I_XP); const float* xs = in_ptr(I_XS); const float* xm = in_ptr(I_MEM); const float* gmix = in_ptr(I_NMIX); const float* gmem = in_ptr(I_MEMN);
        for (int m = gw; m < MA; m += 2 * NGW) {
            int mm[2] = {m, (m + NGW < MA) ? m + NGW : m}; const float* xr[2]; const float* gr[2];
#pragma unroll
            for (int q = 0; q < 2; ++q) { const int r = mm[q];
                if (r < MPROMPT) { xr[q] = xp + (size_t)r * DM; gr[q] = gmix; } else if (r < MTOK) { xr[q] = xs + (size_t)(r - MPROMPT) * DM; gr[q] = gmix; }
                else if (r < MP) { xr[q] = nullptr; gr[q] = gmix; } else { xr[q] = xm + (size_t)(r - MP) * DM; gr[q] = gmem; } }
            if (xr[0] && xr[1]) rms_rows2_to_bf16(lane_id_asm(), xr[0], xr[1], gr[0], gr[1], XN + (size_t)mm[0] * DM, XN + (size_t)mm[1] * DM);
            else {
#pragma unroll
                for (int q = 0; q < 2; ++q) {
                    if (xr[q]) rms_rows2_to_bf16(lane_id_asm(), xr[q], xr[q], gr[q], gr[q], XN + (size_t)mm[q] * DM, XN + (size_t)mm[q] * DM);
                    else { GAS v4u* o = (GAS v4u*)(XN + (size_t)mm[q] * DM) + lane_id_asm(); o[0] = (v4u){0, 0, 0, 0}; o[64] = (v4u){0, 0, 0, 0}; } } }
        }
    }
    float* rope = (float*)(ws + WS_ROPE);
    for (int e = F.bid * 512 + (F.wave * 64 + lane_id_asm()); e < 8193 * 8; e += F.G * 512) {
        const int pos = e >> 3, i = e & 7; const double a = (double)pos * ROPE_INVF[i];
        const double n = __builtin_rint(a * 0.15915494309189535); const float r = (float)(a - n * 6.283185307179586);
        rope[pos * 16 + i] = cosf(r); rope[pos * 16 + 8 + i] = sinf(r);
    }
}
constexpr int NLATE = 16 * 96 + 3 * 8 * 32 + 16 * 32 + 16 * 128 + 64 * 32;
__device__ __forceinline__ void tr_late(int li, LAS float* scr) {
    unsigned char* ws = ws_ptr(); const int lane = lane_id_asm();
    constexpr int L0 = 16 * 96, L2 = 8 * 32, L3 = 16 * 32, L4 = 16 * 128;
    int r = li;
    if (r < L0) { tr_item(in_ptr(I_WIN), 1024, 6144, (bf16*)(ws + WS_WIN), 0, scr, (r / 96) * 192 + 96 + (r % 96), lane, nullptr); return; } r -= L0;
    if (r < L2) { tr_item(in_ptr(I_WBA), 512, 1024, (bf16*)(ws + WS_WBA), 0, scr, r, lane, nullptr); return; } r -= L2;
    if (r < L2) { tr_item(in_ptr(I_WBB), 512, 1024, (bf16*)(ws + WS_WBB), 0, scr, r, lane, nullptr); return; } r -= L2;
    if (r < L2) { tr_item(in_ptr(I_WBC), 512, 1024, (bf16*)(ws + WS_WBC), 0, scr, r, lane, nullptr); return; } r -= L2;
    if (r < L3) { tr_item(in_ptr(I_WOUT), 1024, 1024, (bf16*)(ws + WS_WOUT), 0, scr, r, lane, nullptr); return; } r -= L3;
    if (r < L4) { tr_item(in_ptr(I_WUP), 1024, 4096, (bf16*)(ws + WS_WUP), 0, scr, r, lane, in_ptr(I_NFFN)); return; } r -= L4;
    tr_item(in_ptr(I_WDN), 4096, 1024, (bf16*)(ws + WS_WDN), 0, scr, r, lane, nullptr);
}

struct P1Order {
    pg8::StaticOrder so;
    __device__ bool next(int i, pg8::Unit& u) const {
        long L = (long)i * so.G + so.c; if (L < so.nwg) return so.next(i, u);
        L -= so.nwg; if (L >= 8) return false; u.pm = 65 + (int)(L >> 2); u.pn = 24 + (int)(L & 3); return true;
    }
    __device__ __forceinline__ void a_ready(const pg8::Unit&) const {}
    __device__ __forceinline__ void done(const pg8::Unit&) const {}
};
using pg8::f32x4; using pg8::u32x4; using pg8::HALF; using pg8::BM;
#define EPI_LOOP_BEGIN  _Pragma("unroll") for (int ai = 0; ai < 2; ++ai) _Pragma("unroll") for (int m = 0; m < 4; ++m) { const int row = u.pm * BM + wr * 64 + fr + ai * HALF + m * 16; \
                        _Pragma("unroll") for (int bj = 0; bj < 2; ++bj) { const int col = u.pn * BM + wc * 32 + 8 * fq + bj * HALF; f32x4 v0 = acc[ai][bj][m][0], v1 = acc[ai][bj][m][1];
#define EPI_LOOP_END    } }
__device__ __forceinline__ u32x4 pack_acc(f32x4 v0, f32x4 v1) { u32x4 w; w.x = pg8::cvt_pk_bf16(v0[0], v0[1]); w.y = pg8::cvt_pk_bf16(v0[2], v0[3]); w.z = pg8::cvt_pk_bf16(v1[0], v1[1]); w.w = pg8::cvt_pk_bf16(v1[2], v1[3]); return w; }
struct EpiP1 {
    static constexpr bool PERM = true, AFTER_DRAIN = false;
    pg8::bf16_t* proj; pg8::bf16_t* kvb;
    __device__ __forceinline__ void operator()(const f32x4 (&acc)[2][2][4][2], const pg8::Unit& u, int wr, int wc, int fr, int fq) const {
        const bool memu = u.pm >= 65;
        EPI_LOOP_BEGIN
            const u32x4 w = pack_acc(v0, v1);
            if (memu) *(u32x4*)(kvb + (size_t)(row - 65 * BM) * 1024 + (col - 24 * BM)) = w;
            else *(u32x4*)(proj + (size_t)row * PC + col) = w;
        EPI_LOOP_END
    }
};
struct EpiGate {
    static constexpr bool PERM = true, AFTER_DRAIN = false;
    pg8::bf16_t* gate;
    __device__ __forceinline__ void operator()(const f32x4 (&acc)[2][2][4][2], const pg8::Unit& u, int wr, int wc, int fr, int fq) const {
        EPI_LOOP_BEGIN
#pragma unroll
            for (int e = 0; e < 4; ++e) { v0[e] = 1.f / (1.f + __expf(-v0[e])); v1[e] = 1.f / (1.f + __expf(-v1[e])); }
            *(u32x4*)(gate + (size_t)row * 1024 + col) = pack_acc(v0, v1);
        EPI_LOOP_END
    }
};
template <int MODE> struct EpiBr {
    static constexpr bool PERM = true, AFTER_DRAIN = false;
    const pg8::bf16_t* gate; float* macc; pg8::bf16_t* mrg;
    __device__ __forceinline__ void operator()(const f32x4 (&acc)[2][2][4][2], const pg8::Unit& u, int wr, int wc, int fr, int fq) const {
        EPI_LOOP_BEGIN
            const u32x4 gw = *(const u32x4*)(gate + (size_t)row * 1024 + col);
            float g[8]; unpack8((v4u){gw.x, gw.y, gw.z, gw.w}, g);
            pg8::bf16_t* mp = mrg + (size_t)row * 1024 + col;
            f32x4 a0 = (f32x4){g[0], g[1], g[2], g[3]} * v0, a1 = (f32x4){g[4], g[5], g[6], g[7]} * v1;
            if (MODE >= 1) { const u32x4 pw = *(const u32x4*)mp; float p[8]; unpack8((v4u){pw.x, pw.y, pw.z, pw.w}, p);
                a0 += (f32x4){p[0], p[1], p[2], p[3]}; a1 += (f32x4){p[4], p[5], p[6], p[7]}; }
            *(u32x4*)mp = pack_acc(a0, a1);
        EPI_LOOP_END
    }
};
struct EpiOut {
    static constexpr bool PERM = true, AFTER_DRAIN = false;
    const float* xp; const float* xs; float* out; pg8::bf16_t* x1b; float* sq;
    __device__ __forceinline__ void operator()(const f32x4 (&acc)[2][2][4][2], const pg8::Unit& u, int wr, int wc, int fr, int fq) const {
#pragma unroll
        for (int ai = 0; ai < 2; ++ai)
#pragma unroll
            for (int m = 0; m < 4; ++m) { const int row = u.pm * BM + wr * 64 + fr + ai * HALF + m * 16; float ss = 0.f;
                const float* xr = row < MPROMPT ? xp + (size_t)row * DM : xs + (size_t)(row - MPROMPT) * DM;
#pragma unroll
                for (int bj = 0; bj < 2; ++bj) { const int col = u.pn * BM + wc * 32 + 8 * fq + bj * HALF; f32x4 v0 = acc[ai][bj][m][0], v1 = acc[ai][bj][m][1];
                    if (row < MTOK) { v0 += *(const f32x4*)(xr + col); v1 += *(const f32x4*)(xr + col + 4);
                        *(f32x4*)(out + (size_t)row * DM + col) = v0; *(f32x4*)(out + (size_t)row * DM + col + 4) = v1; }
                    else { v0 = (f32x4){0.f, 0.f, 0.f, 0.f}; v1 = v0; }
                    ss += (v0[0] * v0[0] + v0[1] * v0[1]) + (v0[2] * v0[2] + v0[3] * v0[3]) + (v1[0] * v1[0] + v1[1] * v1[1]) + (v1[2] * v1[2] + v1[3] * v1[3]);
                    *(u32x4*)(x1b + (size_t)row * DM + col) = pack_acc(v0, v1); }
                ss += __shfl_xor(ss, 16); ss += __shfl_xor(ss, 32);
                if (fq == 0) sq[(size_t)row * 16 + u.pn * 4 + wc] = ss; }
    }
};
struct EpiUp {
    static constexpr bool PERM = true, AFTER_DRAIN = false;
    const float* sq; pg8::bf16_t* h;
    __device__ __forceinline__ void operator()(const f32x4 (&acc)[2][2][4][2], const pg8::Unit& u, int wr, int wc, int fr, int fq) const {
#pragma unroll
        for (int ai = 0; ai < 2; ++ai)
#pragma unroll
            for (int m = 0; m < 4; ++m) { const int row = u.pm * BM + wr * 64 + fr + ai * HALF + m * 16;
                const f32x4* sp = (const f32x4*)(sq + (size_t)row * 16); const f32x4 s0 = sp[0], s1 = sp[1], s2 = sp[2], s3 = sp[3];
                const float tot = ((s0[0] + s0[1]) + (s0[2] + s0[3])) + ((s1[0] + s1[1]) + (s1[2] + s1[3])) + ((s2[0] + s2[1]) + (s2[2] + s2[3])) + ((s3[0] + s3[1]) + (s3[2] + s3[3]));
                const float rstd = 1.f / sqrtf(tot * (1.f / 1024.f) + 1e-5f);
#pragma unroll
                for (int bj = 0; bj < 2; ++bj) { const int col = u.pn * BM + wc * 32 + 8 * fq + bj * HALF; f32x4 v0 = acc[ai][bj][m][0] * rstd, v1 = acc[ai][bj][m][1] * rstd;
#pragma unroll
                    for (int e = 0; e < 4; ++e) { const float a = fmaxf(v0[e], 0.f), b = fmaxf(v1[e], 0.f); v0[e] = a * a; v1[e] = b * b; }
                    *(u32x4*)(h + (size_t)row * 4096 + col) = pack_acc(v0, v1); } }
    }
};
struct EpiDown {
    static constexpr bool PERM = true, AFTER_DRAIN = false;
    float* out;
    __device__ __forceinline__ void operator()(const f32x4 (&acc)[2][2][4][2], const pg8::Unit& u, int wr, int wc, int fr, int fq) const {
        EPI_LOOP_BEGIN
            if (row < MTOK) { float* op = out + (size_t)row * DM + col; const f32x4 a0 = *(const f32x4*)op + v0, a1 = *(const f32x4*)(op + 4) + v1; *(f32x4*)op = a0; *(f32x4*)(op + 4) = a1; }
        EPI_LOOP_END
    }
};

template <class SE>
__device__ __forceinline__ void sgemm_block(Frame& F, const bf16* A, int lda, const bf16* Bt, int K, int n_rt, int n_ct, const SE& E) {
    const int lane = lane_id_asm(), c16 = lane & 15, gq = lane >> 4, w = F.wave;
    LAS f32x4* part = (LAS f32x4*)F.lds;
    const int ks = K >> 3;
    for (int bt = F.bid; bt < n_rt * n_ct; bt += F.G) {
        const int rt = bt % n_rt, ct = bt / n_rt;
        const bf16* ap = A + (size_t)(32 * rt + c16) * lda + w * ks + 8 * gq; const bf16* bp = Bt + (size_t)(32 * ct + c16) * K + w * ks + 8 * gq;
        f32x4 acc[2][2];
#pragma unroll
        for (int i = 0; i < 2; ++i)
#pragma unroll
            for (int j = 0; j < 2; ++j) acc[i][j] = (f32x4){0.f, 0.f, 0.f, 0.f};
#pragma unroll 4
        for (int s = 0; s < ks; s += 32) {
            const bf16x8 a0 = *(const bf16x8*)(ap + s), a1 = *(const bf16x8*)(ap + (size_t)16 * lda + s), b0 = *(const bf16x8*)(bp + s), b1 = *(const bf16x8*)(bp + (size_t)16 * K + s);
            acc[0][0] = MFMA16(a0, b0, acc[0][0]); acc[0][1] = MFMA16(a0, b1, acc[0][1]); acc[1][0] = MFMA16(a1, b0, acc[1][0]); acc[1][1] = MFMA16(a1, b1, acc[1][1]);
        }
#pragma unroll
        for (int q = 0; q < 4; ++q) part[(w * 4 + q) * 64 + lane] = acc[q >> 1][q & 1];
        __syncthreads();
        if (w < 4) { f32x4 v = part[w * 64 + lane];
#pragma unroll
            for (int o = 1; o < 8; ++o) v += part[(o * 4 + w) * 64 + lane];
            E.elem(32 * rt + 16 * (w >> 1) + 4 * gq, 32 * ct + 16 * (w & 1) + c16, v); }
        __syncthreads();
    }
}
struct SEpiBf16 { bf16* dst; int ldc;
    __device__ __forceinline__ void elem(int row, int col, f32x4 v) const {
#pragma unroll
        for (int r = 0; r < 4; ++r) dst[(size_t)(row + r) * ldc + col] = (bf16)f2bf(v[r]); } };
struct SEpiGate { bf16* gate;
    __device__ __forceinline__ void elem(int row, int col, f32x4 v) const {
#pragma unroll
        for (int r = 0; r < 4; ++r) gate[(size_t)(row + r) * 1024 + col] = (bf16)f2bf(1.f / (1.f + __expf(-v[r]))); } };
template <int MODE> struct SEpiBr { const bf16* gate; float* macc; bf16* mrg;
    __device__ __forceinline__ void elem(int row, int col, f32x4 v) const {
#pragma unroll
        for (int r = 0; r < 4; ++r) { const size_t o = (size_t)(row + r) * 1024 + col; float a = bf2f(gate[o]) * v[r];
            if (MODE >= 1) a += bf2f(mrg[o]);
            mrg[o] = (bf16)f2bf(a); } } };
struct SEpiOut { const float* xs; float* out; bf16* x1b; float* sqs;
    __device__ __forceinline__ void elem(int row, int col, f32x4 v) const {
#pragma unroll
        for (int r = 0; r < 4; ++r) { const size_t o = (size_t)(row + r) * 1024 + col; const float a = xs[o] + v[r]; out[o] = a; x1b[o] = (bf16)f2bf(a);
            float ss = a * a; ss += dpp_xor1(ss); ss += dpp_xor2(ss); ss += __builtin_bit_cast(float, __builtin_amdgcn_mov_dpp(__builtin_bit_cast(int, ss), 0x141, 0xF, 0xF, true));
            ss += __builtin_bit_cast(float, __builtin_amdgcn_mov_dpp(__builtin_bit_cast(int, ss), 0x140, 0xF, 0xF, true));
            if ((col & 15) == 0) atomicAdd(sqs + row + r, ss); } } };
struct SEpiUp { const float* sqs; bf16* h;
    __device__ __forceinline__ void elem(int row, int col, f32x4 v) const {
#pragma unroll
        for (int r = 0; r < 4; ++r) { const float rstd = 1.f / sqrtf(sqs[row + r] * (1.f / 1024.f) + 1e-5f); const float a = fmaxf(v[r] * rstd, 0.f); h[(size_t)(row + r) * 4096 + col] = (bf16)f2bf(a * a); } } };
struct SEpiDown { float* out;
    __device__ __forceinline__ void elem(int row, int col, f32x4 v) const {
#pragma unroll
        for (int r = 0; r < 4; ++r) out[(size_t)(row + r) * 1024 + col] += v[r]; } };

__device__ __forceinline__ void swa_unit(Frame& F, int b, int kvh, int qb) { unsigned char* wsp_ = ws_ptr(); float* outp_ = out_ptr(); const float* p_i_qn = in_ptr(I_QN); const float* p_i_kn = in_ptr(I_KN); const float* p_i_sink = in_ptr(I_SINK);
    LAS bf16* Ks = (LAS bf16*)F.lds; LAS bf16* Vt = Ks + 256 * 72;
    const bf16* proj = (const bf16*)(wsp_ + WS_PROJ); const float* rope = (const float*)(wsp_ + WS_ROPE);
    const int tid = (F.wave * 64 + lane_id_asm()), lane = lane_id_asm();
    {   const int sub = tid & 7; float gn[8];
#pragma unroll
        for (int j = 0; j < 8; ++j) gn[j] = p_i_kn[8 * sub + j];
#pragma unroll
        for (int pass = 0; pass < 4; ++pass) {
            const int kk = pass * 64 + (tid >> 3), tk = 128 * (qb - 1) + kk; const bool valid = tk >= 0; const size_t m = (size_t)b * TSEQ + (valid ? tk : 0);
            float x[8], vv[8]; unpack8(*(const v4u*)(proj + m * PC + C_K + 64 * kvh + 8 * sub), x); unpack8(*(const v4u*)(proj + m * PC + C_V + 64 * kvh + 8 * sub), vv);
            float ss = 0.f;
#pragma unroll
            for (int j = 0; j < 8; ++j) ss += x[j] * x[j];
            ss += __shfl_xor(ss, 1); ss += __shfl_xor(ss, 2); ss += __shfl_xor(ss, 4);
            const float rstd = 1.f / sqrtf(ss * (1.f / 64.f) + 1e-5f);
            const float* rp = rope + (size_t)(valid ? tk : 0) * 16;
#pragma unroll
            for (int j = 0; j < 8; ++j) { x[j] = x[j] * rstd * gn[j]; const float other = __shfl_xor(x[j], 1); const float c = rp[j], s = rp[8 + j];
                if (sub == 0) x[j] = x[j] * c - other * s; else if (sub == 1) x[j] = x[j] * c + other * s; }
            if (!valid) {
#pragma unroll
                for (int j = 0; j < 8; ++j) { x[j] = 0.f; vv[j] = 0.f; } }
            *(LAS v4u*)(Ks + kk * 72 + 8 * sub) = pack8(x);
#pragma unroll
            for (int j = 0; j < 8; ++j) Vt[(8 * sub + j) * 264 + kk] = (bf16)f2bf(vv[j]);
            if (qb == 63 && kk >= 128) { const size_t o = ((size_t)(b * 128 + (kk - 128)) * 2 + kvh) * 64 + 8 * sub;
#pragma unroll
                for (int j = 0; j < 8; ++j) { outp_[O_KP + o + j] = x[j]; outp_[O_VP + o + j] = vv[j]; } }
        }
    }
    __syncthreads();
    const int q = lane & 15, gq = lane >> 4;
    bf16* ob = (bf16*)(wsp_ + WS_OB);
    for (int mi = 0; mi < 4; ++mi) {
        const int mt = F.wave * 4 + mi, g = mt >> 3, tb = mt & 7, head = 4 * kvh + g;
        const int qi = 16 * tb + q, tq = 128 * qb + qi; const size_t m = (size_t)b * TSEQ + tq;
        float x0[8], x1[8]; unpack8(*(const v4u*)(proj + m * PC + C_Q + 64 * head + 8 * gq), x0); unpack8(*(const v4u*)(proj + m * PC + C_Q + 64 * head + 32 + 8 * gq), x1);
        float ss = 0.f;
#pragma unroll
        for (int j = 0; j < 8; ++j) ss += x0[j] * x0[j] + x1[j] * x1[j];
        ss += __shfl_xor(ss, 16); ss += __shfl_xor(ss, 32);
        const float rstd = 0.125f / sqrtf(ss * (1.f / 64.f) + 1e-5f);
        const float* rp = rope + (size_t)tq * 16;
#pragma unroll
        for (int j = 0; j < 8; ++j) { x0[j] = x0[j] * rstd * p_i_qn[8 * gq + j]; x1[j] = x1[j] * rstd * p_i_qn[32 + 8 * gq + j];
            const float other = __shfl_xor(x0[j], 16); const float c = rp[j], s = rp[8 + j];
            if (gq == 0) x0[j] = x0[j] * c - other * s; else if (gq == 1) x0[j] = x0[j] * c + other * s; }
        const bf16x8 qf0 = as_frag(pack8(x0)), qf1 = as_frag(pack8(x1));
        f32x4 acc[10];
#pragma unroll
        for (int kt = 0; kt < 9; ++kt) { const LAS bf16* kp = Ks + (16 * (tb + kt) + q) * 72 + 8 * gq;
            f32x4 a = (f32x4){0.f, 0.f, 0.f, 0.f};
            a = MFMA16(*(const LAS bf16x8*)kp, qf0, a); a = MFMA16(*(const LAS bf16x8*)(kp + 32), qf1, a); acc[kt] = a; __builtin_amdgcn_sched_barrier(0); }
        acc[9] = (f32x4){0.f, 0.f, 0.f, 0.f};
        const float sink = p_i_sink[head]; float mx = sink;
#pragma unroll
        for (int kt = 0; kt < 9; ++kt)
#pragma unroll
            for (int r = 0; r < 4; ++r) { const int kk = 16 * (tb + kt) + 4 * gq + r; const bool ok = kk >= qi && kk <= qi + 128 && (qb > 0 || kk >= 128);
                acc[kt][r] = ok ? acc[kt][r] : -INFINITY; mx = fmaxf(mx, acc[kt][r]); }
        mx = fmaxf(mx, __shfl_xor(mx, 16)); mx = fmaxf(mx, __shfl_xor(mx, 32));
        float ls = 0.f;
#pragma unroll
        for (int kt = 0; kt < 9; ++kt)
#pragma unroll
            for (int r = 0; r < 4; ++r) { const float p = __expf(acc[kt][r] - mx); acc[kt][r] = p; ls += p; }
        ls += __shfl_xor(ls, 16); ls += __shfl_xor(ls, 32); ls += __expf(sink - mx);
        f32x4 o[4];
#pragma unroll
        for (int dt = 0; dt < 4; ++dt) o[dt] = (f32x4){0.f, 0.f, 0.f, 0.f};
#pragma unroll
        for (int s = 0; s < 5; ++s) {
            v4u pw; pw.x = pk2(acc[2 * s][0], acc[2 * s][1]); pw.y = pk2(acc[2 * s][2], acc[2 * s][3]); pw.z = pk2(acc[2 * s + 1][0], acc[2 * s + 1][1]); pw.w = pk2(acc[2 * s + 1][2], acc[2 * s + 1][3]);
            const bf16x8 pf = as_frag(pw);
            const int t0 = tb + 2 * s, t1 = (t0 + 1 <= 15) ? t0 + 1 : 15;
#pragma unroll
            for (int dt = 0; dt < 4; ++dt) { const LAS bf16* vp = Vt + (16 * dt + q) * 264 + 4 * gq;
                typedef unsigned u32x2 __attribute__((ext_vector_type(2)));
                const u32x2 lo = *(const LAS u32x2*)(vp + 16 * t0), hi = *(const LAS u32x2*)(vp + 16 * t1);
                o[dt] = MFMA16(as_frag((v4u){lo.x, lo.y, hi.x, hi.y}), pf, o[dt]); }
            __builtin_amdgcn_sched_barrier(0);
        }
        const float il = 1.f / ls;
#pragma unroll
        for (int dt = 0; dt < 4; ++dt) { typedef unsigned u32x2 __attribute__((ext_vector_type(2)));
            u32x2 w; w.x = pk2(o[dt][0] * il, o[dt][1] * il); w.y = pk2(o[dt][2] * il, o[dt][3] * il);
            *(u32x2*)(ob + m * 512 + 64 * head + 16 * dt + 4 * gq) = w; }
    }
    __syncthreads();
}

__device__ __forceinline__ void mem_prep(Frame& F, int b, int hm) { unsigned char* wsp_ = ws_ptr(); float* outp_ = out_ptr(); const float* p_i_xkn = in_ptr(I_XKN);
    const bf16* kvb = (const bf16*)(wsp_ + WS_KVB);
    bf16* mkn = (bf16*)(wsp_ + WS_MKN) + (size_t)(b * 4 + hm) * 32768; bf16* mvt = (bf16*)(wsp_ + WS_MVT) + (size_t)(b * 4 + hm) * 32768;
    const int tid = (F.wave * 64 + lane_id_asm());
    const int sub = tid & 15; float gn[8];
#pragma unroll
    for (int j = 0; j < 8; ++j) gn[j] = p_i_xkn[8 * sub + j];
#pragma unroll 2
    for (int pass = 0; pass < 8; ++pass) {
        const int mm = pass * 32 + (tid >> 4); const size_t r = (size_t)(b * 256 + mm) * 1024 + 128 * hm + 8 * sub;
        float x[8], vv[8]; unpack8(*(const v4u*)(kvb + r), x); unpack8(*(const v4u*)(kvb + r + 512), vv);
        float ss = 0.f;
#pragma unroll
        for (int j = 0; j < 8; ++j) ss += x[j] * x[j];
        ss += __shfl_xor(ss, 1); ss += __shfl_xor(ss, 2); ss += __shfl_xor(ss, 4); ss += __shfl_xor(ss, 8);
        const float rstd = 1.f / sqrtf(ss * (1.f / 128.f) + 1e-5f);
#pragma unroll
        for (int j = 0; j < 8; ++j) x[j] = x[j] * rstd * gn[j];
        *(v4u*)(mkn + (size_t)mm * 128 + 8 * sub) = pack8(x);
#pragma unroll
        for (int j = 0; j < 8; ++j) mvt[(size_t)(8 * sub + j) * 256 + mm] = (bf16)f2bf(vv[j]);
        const size_t o = ((size_t)(b * 256 + mm) * 4 + hm) * 128 + 8 * sub;
#pragma unroll
        for (int j = 0; j < 8; ++j) { outp_[O_MKP + o + j] = x[j]; outp_[O_MVP + o + j] = vv[j]; }
    }
}

__device__ __forceinline__ void mem_unit(Frame& F, int b, int hm, int tb) { unsigned char* wsp_ = ws_ptr(); float* outp_ = out_ptr(); const float* p_i_xqn = in_ptr(I_XQN); const float* p_i_xkn = in_ptr(I_XKN);
    LAS bf16* Km = (LAS bf16*)F.lds; LAS bf16* Vt = Km + 256 * 136;
    const bf16* proj = (const bf16*)(wsp_ + WS_PROJ); const bf16* kvb = (const bf16*)(wsp_ + WS_KVB);
    const int tid = (F.wave * 64 + lane_id_asm()), lane = lane_id_asm();
    {   const bf16* mkn = (const bf16*)(wsp_ + WS_MKN) + (size_t)(b * 4 + hm) * 32768; const bf16* mvt = (const bf16*)(wsp_ + WS_MVT) + (size_t)(b * 4 + hm) * 32768;
        v4u kr[8], vr[8];
#pragma unroll
        for (int i = 0; i < 8; ++i) { const int c = tid + 512 * i; kr[i] = *(const v4u*)(mkn + (size_t)c * 8); vr[i] = *(const v4u*)(mvt + (size_t)c * 8); }
#pragma unroll
        for (int i = 0; i < 8; ++i) { const int c = tid + 512 * i;
            *(LAS v4u*)(Km + (c >> 4) * 136 + 8 * (c & 15)) = kr[i]; *(LAS v4u*)(Vt + (c >> 5) * 264 + 8 * (c & 31)) = vr[i]; }
    }
    __syncthreads();
    const int q = lane & 15, gq = lane >> 4;
    bf16* oc = (bf16*)(wsp_ + WS_OC);
    for (int mi = 0; mi < 2; ++mi) {
        const int mt = F.wave * 2 + mi; const size_t m = (size_t)b * TSEQ + 256 * tb + 16 * mt + q;
        bf16x8 qf[4];
        {   float x[4][8]; float ss = 0.f;
#pragma unroll
            for (int ks = 0; ks < 4; ++ks) { unpack8(*(const v4u*)(proj + m * PC + C_XQ + 128 * hm + 32 * ks + 8 * gq), x[ks]);
#pragma unroll
                for (int j = 0; j < 8; ++j) ss += x[ks][j] * x[ks][j]; }
            ss += __shfl_xor(ss, 16); ss += __shfl_xor(ss, 32);
            const float rstd = 0.08838834764831845f / sqrtf(ss * (1.f / 128.f) + 1e-5f);
#pragma unroll
            for (int ks = 0; ks < 4; ++ks) {
#pragma unroll
                for (int j = 0; j < 8; ++j) x[ks][j] = x[ks][j] * rstd * p_i_xqn[32 * ks + 8 * gq + j];
                qf[ks] = as_frag(pack8(x[ks])); }
        }
        f32x4 acc[16]; float mx = -INFINITY;
#pragma unroll
        for (int kt = 0; kt < 16; ++kt) { const LAS bf16* kp = Km + (16 * kt + q) * 136 + 8 * gq; f32x4 a = (f32x4){0.f, 0.f, 0.f, 0.f};
#pragma unroll
            for (int ks = 0; ks < 4; ++ks) a = MFMA16(*(const LAS bf16x8*)(kp + 32 * ks), qf[ks], a);
            acc[kt] = a; mx = fmaxf(mx, fmaxf(fmaxf(a[0], a[1]), fmaxf(a[2], a[3]))); __builtin_amdgcn_sched_barrier(0); }
        mx = fmaxf(mx, __shfl_xor(mx, 16)); mx = fmaxf(mx, __shfl_xor(mx, 32));
        float ls = 0.f;
#pragma unroll
        for (int kt = 0; kt < 16; ++kt)
#pragma unroll
            for (int r = 0; r < 4; ++r) { const float p = __expf(acc[kt][r] - mx); acc[kt][r] = p; ls += p; }
        ls += __shfl_xor(ls, 16); ls += __shfl_xor(ls, 32);
        f32x4 o[8];
#pragma unroll
        for (int dt = 0; dt < 8; ++dt) o[dt] = (f32x4){0.f, 0.f, 0.f, 0.f};
#pragma unroll
        for (int s = 0; s < 8; ++s) {
            v4u pw; pw.x = pk2(acc[2 * s][0], acc[2 * s][1]); pw.y = pk2(acc[2 * s][2], acc[2 * s][3]); pw.z = pk2(acc[2 * s + 1][0], acc[2 * s + 1][1]); pw.w = pk2(acc[2 * s + 1][2], acc[2 * s + 1][3]);
            const bf16x8 pf = as_frag(pw);
#pragma unroll
            for (int dt = 0; dt < 8; ++dt) { const LAS bf16* vp = Vt + (16 * dt + q) * 264 + 32 * s + 4 * gq;
                typedef unsigned u32x2 __attribute__((ext_vector_type(2)));
                const u32x2 lo = *(const LAS u32x2*)vp, hi = *(const LAS u32x2*)(vp + 16);
                o[dt] = MFMA16(as_frag((v4u){lo.x, lo.y, hi.x, hi.y}), pf, o[dt]); }
            __builtin_amdgcn_sched_barrier(0);
        }
        const float il = 1.f / ls;
#pragma unroll
        for (int dt = 0; dt < 8; ++dt) { typedef unsigned u32x2 __attribute__((ext_vector_type(2)));
            u32x2 w; w.x = pk2(o[dt][0] * il, o[dt][1] * il); w.y = pk2(o[dt][2] * il, o[dt][3] * il);
            *(u32x2*)(oc + m * 512 + 128 * hm + 16 * dt + 4 * gq) = w; }
    }
    __syncthreads();
}

template <int CTRL> __device__ __forceinline__ float dppq2(float x) { return __builtin_bit_cast(float, __builtin_amdgcn_mov_dpp(__builtin_bit_cast(int, x), CTRL, 0xF, 0xF, true)); }
template <int CTRL, int RM> __device__ __forceinline__ float dppk2(float x) { return __builtin_bit_cast(float, __builtin_amdgcn_update_dpp(__builtin_bit_cast(int, x), __builtin_bit_cast(int, x), CTRL, RM, 0xF, false)); }
template <int CTRL, int RM> __device__ __forceinline__ float dppz2(float x) { return __builtin_bit_cast(float, __builtin_amdgcn_update_dpp(0, __builtin_bit_cast(int, x), CTRL, RM, 0xF, false)); }
__device__ __forceinline__ float wsum2(float v) { v += dppq2<0xB1>(v); v += dppq2<0x4E>(v); v += dppq2<0x141>(v); v += dppq2<0x140>(v); v += dppz2<0x142, 0xA>(v); v += dppz2<0x143, 0xC>(v);
    return __builtin_bit_cast(float, __builtin_amdgcn_readlane(__builtin_bit_cast(int, v), 63)); }
__device__ __forceinline__ float wmax2(float v) { v = fmaxf(v, dppq2<0xB1>(v)); v = fmaxf(v, dppq2<0x4E>(v)); v = fmaxf(v, dppq2<0x141>(v)); v = fmaxf(v, dppq2<0x140>(v)); v = fmaxf(v, dppk2<0x142, 0xA>(v)); v = fmaxf(v, dppk2<0x143, 0xC>(v));
    return __builtin_bit_cast(float, __builtin_amdgcn_readlane(__builtin_bit_cast(int, v), 63)); }
__device__ __forceinline__ void swa_sample_task(Frame& F, LAS float* wl, int bs, int kvh) { unsigned char* wsp_ = ws_ptr(); float* outp_ = out_ptr(); const float* p_i_ck = in_ptr(I_CK); const float* p_i_cv = in_ptr(I_CV); const float* p_i_qn = in_ptr(I_QN); const float* p_i_kn = in_ptr(I_KN); const float* p_i_sink = in_ptr(I_SINK);
    int lane = lane_id_asm(); asm volatile("" : "+v"(lane)); const size_t m = MPROMPT + bs;
    const bf16* prow = (const bf16*)(wsp_ + WS_PROJ) + m * PC; const float* rp = (const float*)(wsp_ + WS_ROPE) + (size_t)8192 * 16;
    LAS float* qs = wl;
    LAS float* kn = wl + 256;
    LAS float* vn = wl + 320;
    LAS float* pp = wl + 384;
    const float* ck = p_i_ck + (size_t)bs * 16384 + 64 * kvh; const float* cv = p_i_cv + (size_t)bs * 16384 + 64 * kvh;
    float* ok = outp_ + O_KS + (size_t)bs * 16384 + 64 * kvh; float* ov = outp_ + O_VS + (size_t)bs * 16384 + 64 * kvh;
    const float c = rp[lane & 7], s = rp[8 + (lane & 7)];
#pragma unroll
    for (int h = 0; h < 5; ++h) {
        const float x = bf2f(h < 4 ? prow[C_Q + 64 * (4 * kvh + h) + lane] : prow[C_K + 64 * kvh + lane]);
        const float rstd = __builtin_amdgcn_rsqf(wsum2(x * x) * (1.f / 64.f) + 1e-5f);
        float y = x * rstd * (h < 4 ? p_i_qn[lane] : p_i_kn[lane]);
        const float other = __shfl_xor(y, 8);
        if (lane < 8) y = y * c - other * s; else if (lane < 16) y = y * c + other * s;
        if (h < 4) qs[64 * h + lane] = y * 0.125f; else { kn[lane] = y; ok[127 * 128 + lane] = y; }
    }
    { const float v = bf2f(prow[C_V + 64 * kvh + lane]); vn[lane] = v; ov[127 * 128 + lane] = v; }
    float sc[2][4];
#pragma unroll
    for (int ps = 0; ps < 2; ++ps) { const float* kr = ck + (size_t)(lane + 64 * ps) * 128; float a0 = 0.f, a1 = 0.f, a2 = 0.f, a3 = 0.f;
#pragma unroll 8
        for (int d4 = 0; d4 < 16; ++d4) { const f32x4 k4 = *(const f32x4*)(kr + 4 * d4);
            const f32x4 q0 = *(const LAS f32x4*)(qs + 4 * d4), q1 = *(const LAS f32x4*)(qs + 64 + 4 * d4), q2 = *(const LAS f32x4*)(qs + 128 + 4 * d4), q3 = *(const LAS f32x4*)(qs + 192 + 4 * d4);
            a0 += k4[0] * q0[0] + k4[1] * q0[1] + k4[2] * q0[2] + k4[3] * q0[3]; a1 += k4[0] * q1[0] + k4[1] * q1[1] + k4[2] * q1[2] + k4[3] * q1[3];
            a2 += k4[0] * q2[0] + k4[1] * q2[1] + k4[2] * q2[2] + k4[3] * q2[3]; a3 += k4[0] * q3[0] + k4[1] * q3[1] + k4[2] * q3[2] + k4[3] * q3[3]; }
        sc[ps][0] = a0; sc[ps][1] = a1; sc[ps][2] = a2; sc[ps][3] = a3; }
    float linv[4];
#pragma unroll
    for (int h = 0; h < 4; ++h) {
        const float sn = wsum2(qs[64 * h + lane] * kn[lane]); const float sink = p_i_sink[4 * kvh + h];
        const float mx = fmaxf(fmaxf(wmax2(fmaxf(sc[0][h], sc[1][h])), sn), sink);
        const float p0 = __expf(sc[0][h] - mx), p1 = __expf(sc[1][h] - mx), pn = __expf(sn - mx);
        const float l = wsum2(p0 + p1) + pn + __expf(sink - mx);
        pp[132 * h + lane] = p0; pp[132 * h + 64 + lane] = p1; if (lane == 0) pp[132 * h + 128] = pn; linv[h] = 1.f / l;
    }
    bf16* ob = (bf16*)(wsp_ + WS_OB) + m * 512 + 256 * kvh;
    float o0 = 0.f, o1 = 0.f, o2 = 0.f, o3 = 0.f;
#pragma unroll 16
    for (int key = 0; key < 128; ++key) { const float v = cv[(size_t)key * 128 + lane];
        o0 += pp[key] * v; o1 += pp[132 + key] * v; o2 += pp[264 + key] * v; o3 += pp[396 + key] * v; }
    { const float v = vn[lane]; o0 += pp[128] * v; o1 += pp[132 + 128] * v; o2 += pp[264 + 128] * v; o3 += pp[396 + 128] * v; }
    ob[lane] = (bf16)f2bf(o0 * linv[0]); ob[64 + lane] = (bf16)f2bf(o1 * linv[1]); ob[128 + lane] = (bf16)f2bf(o2 * linv[2]); ob[192 + lane] = (bf16)f2bf(o3 * linv[3]);
}
__device__ __forceinline__ void swa_copy_task(int bs) { float* outp_ = out_ptr(); const float* ck = in_ptr(I_CK) + (size_t)bs * 16384; const float* cv = in_ptr(I_CV) + (size_t)bs * 16384;
    float* ok = outp_ + O_KS + (size_t)bs * 16384; float* ov = outp_ + O_VS + (size_t)bs * 16384;
    int lane = lane_id_asm(); asm volatile("" : "+v"(lane));
#pragma unroll 8
    for (int i = lane; i < 127 * 32; i += 64) { ((f32x4*)ok)[i] = ((const f32x4*)ck)[i + 32]; ((f32x4*)ov)[i] = ((const f32x4*)cv)[i + 32]; }
}
__device__ __forceinline__ void mem_sample_task(Frame& F, LAS float* wl, int bs, int hm) { unsigned char* wsp_ = ws_ptr(); const float* p_i_cmk = in_ptr(I_CMK); const float* p_i_cmv = in_ptr(I_CMV); const float* p_i_xqn = in_ptr(I_XQN);
    int lane = lane_id_asm(); asm volatile("" : "+v"(lane)); const size_t m = MPROMPT + bs;
    const bf16* prow = (const bf16*)(wsp_ + WS_PROJ) + m * PC;
    LAS float* sc = wl;
    const int half = lane >> 5, d4 = 4 * (lane & 31);
    float q4[4];
    {   float x[4]; float ss = 0.f;
#pragma unroll
        for (int e = 0; e < 4; ++e) { x[e] = bf2f(prow[C_XQ + 128 * hm + d4 + e]); ss += x[e] * x[e]; }
        ss += __shfl_xor(ss, 1); ss += __shfl_xor(ss, 2); ss += __shfl_xor(ss, 4); ss += __shfl_xor(ss, 8); ss += __shfl_xor(ss, 16);
        const float rstd = 0.08838834764831845f / sqrtf(ss * (1.f / 128.f) + 1e-5f);
#pragma unroll
        for (int e = 0; e < 4; ++e) q4[e] = x[e] * rstd * p_i_xqn[d4 + e]; }
    const float* kb = p_i_cmk + ((size_t)bs * 256 * 4 + hm) * 128 + d4; const float* vb = p_i_cmv + ((size_t)bs * 256 * 4 + hm) * 128 + d4;
#pragma unroll 4
    for (int i = 0; i < 128; i += 4) {
        float part[4];
#pragma unroll
        for (int u = 0; u < 4; ++u) { const f32x4 k4 = *(const f32x4*)(kb + (size_t)(2 * (i + u) + half) * 512); part[u] = k4[0] * q4[0] + k4[1] * q4[1] + k4[2] * q4[2] + k4[3] * q4[3]; }
#pragma unroll
        for (int u = 0; u < 4; ++u) { float p = part[u]; p += dppq2<0xB1>(p); p += dppq2<0x4E>(p); p += dppq2<0x141>(p); p += dppq2<0x140>(p); p += __shfl_xor(p, 16);
            if ((lane & 31) == 0) sc[2 * (i + u) + half] = p; }
    }
    float s4[4]; float mx = -INFINITY;
#pragma unroll
    for (int e = 0; e < 4; ++e) { s4[e] = sc[lane + 64 * e]; mx = fmaxf(mx, s4[e]); }
    mx = wave_max(mx); float l = 0.f;
#pragma unroll
    for (int e = 0; e < 4; ++e) { s4[e] = __expf(s4[e] - mx); l += s4[e]; }
    l = wave_sum(l);
#pragma unroll
    for (int e = 0; e < 4; ++e) sc[lane + 64 * e] = s4[e];
    f32x4 o = (f32x4){0.f, 0.f, 0.f, 0.f};
#pragma unroll 4
    for (int i = 0; i < 128; i += 4) {
#pragma unroll
        for (int u = 0; u < 4; ++u) { const int key = 2 * (i + u) + half; const f32x4 v4 = *(const f32x4*)(vb + (size_t)key * 512); o += v4 * sc[key]; }
    }
#pragma unroll
    for (int e = 0; e < 4; ++e) o[e] += __shfl_xor(o[e], 32);
    if (half == 0) { const float il = 1.f / l; typedef unsigned u32x2 __attribute__((ext_vector_type(2)));
        u32x2 w; w.x = pk2(o[0] * il, o[1] * il); w.y = pk2(o[2] * il, o[3] * il);
        *(u32x2*)((bf16*)(wsp_ + WS_OC) + m * 512 + 128 * hm + d4) = w; }
}

template <int CTRL> __device__ __forceinline__ float dppq(float x) { return __builtin_bit_cast(float, __builtin_amdgcn_mov_dpp(__builtin_bit_cast(int, x), CTRL, 0xF, 0xF, true)); }
template <int CTRL, int RM> __device__ __forceinline__ float dpp0(float x) { return __builtin_bit_cast(float, __builtin_amdgcn_update_dpp(0, __builtin_bit_cast(int, x), CTRL, RM, 0xF, false)); }
__device__ __forceinline__ float wave_sum_fast(float v) {
    v += dppq<0xB1>(v); v += dppq<0x4E>(v); v += dppq<0x141>(v); v += dppq<0x140>(v);
    v += dpp0<0x142, 0xA>(v); v += dpp0<0x143, 0xC>(v);
    return __builtin_bit_cast(float, __builtin_amdgcn_readlane(__builtin_bit_cast(int, v), 63));
}
template <int MODE>
__device__ __forceinline__ void rwkv_task(Frame& F, LAS float* wl, int h, int m0, int t0, int ngrp, float* lbuf, bf16* pth, bf16* ptl, float* s_out, int sub_lo, int sub_hi) { unsigned char* wsp_ = ws_ptr(); float* outp_ = out_ptr(); const float* p_i_srw = in_ptr(I_SRW); const float* p_i_shift = in_ptr(I_SHIFT); const float* p_i_mu = in_ptr(I_MU); const float* p_i_w0 = in_ptr(I_W0); const float* p_i_a0 = in_ptr(I_A0); const float* p_i_kk = in_ptr(I_KK); const float* p_i_ka = in_ptr(I_KA); const float* p_i_rk = in_ptr(I_RK); const float* p_i_lnw = in_ptr(I_LNW); const float* p_i_lnb = in_ptr(I_LNB);
    constexpr bool SAMPLE = (MODE == 0);
    const int lane0 = lane_id_asm(); const int ch = 64 * h + lane0;
    const bf16* proj = (const bf16*)(wsp_ + WS_PROJ);
    const bf16* w2t = (const bf16*)(wsp_ + WS_W2T); const bf16* a2t = (const bf16*)(wsp_ + WS_A2T); const bf16* g2t = (const bf16*)(wsp_ + WS_G2T);
    const float* mu = p_i_mu;
    LAS float* dec = wl; LAS float* aa = wl + 1024; LAS bf16* gg = (LAS bf16*)(wl + 2048); LAS float* vec = wl + 2560; LAS float* ybuf = wl + 4096; LAS float* bonl = wl + 4352;
    const float mu_r = mu[ch], mu_k = mu[512 + ch], mu_v = mu[1024 + ch], kk_c = p_i_kk[ch], ka_c = p_i_ka[ch], rk_c = p_i_rk[ch], lnw = p_i_lnw[ch], lnb = p_i_lnb[ch];
    typedef float f2 __attribute__((ext_vector_type(2)));
    f2 S2[4][8]; f2 Pm2[MODE == 1 ? 4 : 1][8];
    {   const int vb = lane0 >> 2, kb = lane0 & 3;
#pragma unroll
        for (int i = 0; i < 4; ++i)
#pragma unroll
            for (int j = 0; j < 16; ++j) { S2[i][j >> 1][j & 1] = 0.f; if (MODE == 1) Pm2[i][j >> 1][j & 1] = (4 * vb + i == 16 * kb + j) ? 1.f : 0.f; }
        if (MODE == 2 && lbuf) { const float* sp = lbuf + (size_t)(4 * vb) * 64 + 16 * kb;
#pragma unroll
            for (int i = 0; i < 4; ++i)
#pragma unroll
                for (int q4 = 0; q4 < 4; ++q4) { const f32x4 t = *(const f32x4*)(sp + i * 64 + 4 * q4); S2[i][2 * q4] = (f2){t[0], t[1]}; S2[i][2 * q4 + 1] = (f2){t[2], t[3]}; } }
    }
    bf16* oa = (bf16*)(wsp_ + WS_OA);
#pragma unroll 1
    for (int grp = 0; grp < ngrp; ++grp) {
        {   int ln = lane0; asm volatile("" : "+v"(ln)); const int c16 = ln & 15, gq = ln >> 4;
            const int m = m0 + 16 * grp + c16; const bool first = (!SAMPLE) && (t0 + 16 * grp + c16 == 0);
            bf16x8 af[8]; const float* mup = mu; asm volatile("" : "+s"(mup));
#pragma unroll
            for (int f = 0; f < 8; ++f) {
                const int col = 1536 + 32 * f + 8 * gq;
                float z[8], zp[8]; unpack8(*(const v4u*)(proj + (size_t)m * PC + col), z);
                if (SAMPLE) { const float* sp = p_i_shift + (size_t)(m - MPROMPT) * ZC + col; const f32x4 a = *(const f32x4*)sp, b = *(const f32x4*)(sp + 4);
                    zp[0] = a[0]; zp[1] = a[1]; zp[2] = a[2]; zp[3] = a[3]; zp[4] = b[0]; zp[5] = b[1]; zp[6] = b[2]; zp[7] = b[3]; }
                else { unpack8(*(const v4u*)(proj + (size_t)(first ? m : m - 1) * PC + col), zp);
                    if (first) {
#pragma unroll
                        for (int j = 0; j < 8; ++j) zp[j] = 0.f; } }
                const f32x4 m0v = *(const f32x4*)(mup + col), m1v = *(const f32x4*)(mup + col + 4);
#pragma unroll
                for (int j = 0; j < 8; ++j) { const float mj = j < 4 ? m0v[j] : m1v[j - 4]; float v = z[j] + (zp[j] - z[j]) * mj;
                    if (f < 2) { const float e2 = __expf(2.f * v); v = 1.f - 2.f * __builtin_amdgcn_rcpf(e2 + 1.f); } else if (f >= 4) v = __builtin_amdgcn_rcpf(1.f + __expf(-v)); z[j] = v; }
                af[f] = as_frag(pack8(z));
            }
#pragma unroll
            for (int nt = 0; nt < 4; ++nt) { const int n = 64 * h + 16 * nt + c16;
                const bf16* wp = w2t + n * 64 + 8 * gq; const bf16* ap = a2t + n * 64 + 8 * gq; const bf16* gp = g2t + n * 128 + 8 * gq;
                f32x4 accw = (f32x4){0.f, 0.f, 0.f, 0.f}, acca = accw, accg = accw;
                accw = MFMA16(af[0], *(const bf16x8*)wp, accw); accw = MFMA16(af[1], *(const bf16x8*)(wp + 32), accw);
                acca = MFMA16(af[2], *(const bf16x8*)ap, acca); acca = MFMA16(af[3], *(const bf16x8*)(ap + 32), acca);
                if (MODE != 1) {
#pragma unroll
                    for (int f = 0; f < 4; ++f) accg = MFMA16(af[4 + f], *(const bf16x8*)(gp + 32 * f), accg); }
                const float w0v = p_i_w0[n], a0v = p_i_a0[n];
#pragma unroll
                for (int r = 0; r < 4; ++r) { const int tl = 4 * gq + r, cc = 16 * nt + c16;
                    const float x = -(w0v + accw[r]);
                    const float sp = fmaxf(x, 0.f) + __logf(1.f + __expf(-fabsf(x)));
                    dec[tl * 64 + cc] = __expf(-__expf(-sp - 0.5f));
                    aa[tl * 64 + cc] = __builtin_amdgcn_rcpf(1.f + __expf(-(a0v + acca[r])));
                    if (MODE != 1) gg[tl * 64 + cc] = (bf16)f2bf(accg[r]); }
            }
        }
#define RW_LOADZ(SUB) do { _Pragma("unroll") for (int tt = 0; tt < 4; ++tt) { const int tl_ = 4 * (SUB) + tt, m_ = m0 + 16 * grp + tl_; const bf16* zr = proj + (size_t)m_ * PC + ch; \
            cz[tt][0] = MODE == 1 ? 0.f : bf2f(zr[0]); cz[tt][1] = bf2f(zr[512]); cz[tt][2] = bf2f(zr[1024]); \
            if (SAMPLE) { const float* sp = p_i_shift + (size_t)(m_ - MPROMPT) * ZC + ch; pz[tt][0] = sp[0]; pz[tt][1] = sp[512]; pz[tt][2] = sp[1024]; } \
            else if (t0 + 16 * grp + tl_ == 0) { pz[tt][0] = 0.f; pz[tt][1] = 0.f; pz[tt][2] = 0.f; } \
            else { pz[tt][0] = MODE == 1 ? 0.f : bf2f(zr[-PC]); pz[tt][1] = bf2f(zr[512 - PC]); pz[tt][2] = bf2f(zr[1024 - PC]); } } } while (0)
        float cz[4][3], pz[4][3];
        RW_LOADZ(sub_lo);
#pragma unroll 1
        for (int sub = sub_lo; sub < sub_hi; ++sub) {
            int lane = lane0; asm volatile("" : "+v"(lane)); const int vb = lane >> 2, kb = lane & 3;
#pragma unroll
            for (int tt = 0; tt < 4; ++tt) {
                const int tl = 4 * sub + tt;
                const float r = cz[tt][0] + (pz[tt][0] - cz[tt][0]) * mu_r, k = cz[tt][1] + (pz[tt][1] - cz[tt][1]) * mu_k, v = cz[tt][2] + (pz[tt][2] - cz[tt][2]) * mu_v;
                const float a = aa[tl * 64 + lane], d = dec[tl * 64 + lane];
                const float kk0 = k * kk_c; const float kk = kk0 * __builtin_amdgcn_rsqf(fmaxf(wave_sum_fast(kk0 * kk0), 1e-24f));
                const float kh = k * (1.f + (a - 1.f) * ka_c);
                LAS float* vp = vec + tt * 384;
                vp[lane] = d; vp[64 + lane] = kk; vp[128 + lane] = kk * a; vp[192 + lane] = kh; if (MODE != 1) vp[256 + lane] = r; vp[320 + lane] = v;
                if (MODE != 1) { const float bon = wave_sum_fast(r * kh * rk_c); if (lane == 0) bonl[tt] = bon; }
            }
            if (sub + 1 < sub_hi) RW_LOADZ(sub + 1);
#pragma unroll 1
            for (int tt = 0; tt < 4; ++tt) {
                const int tl = 4 * sub + tt, m = m0 + 16 * grp + tl;
                if (SAMPLE) { const float* sp = p_i_srw + (((size_t)(m - MPROMPT) * 8 + h) * 64 + 4 * vb) * 64 + 16 * kb;
#pragma unroll
                    for (int i = 0; i < 4; ++i)
#pragma unroll
                        for (int q4 = 0; q4 < 4; ++q4) { const f32x4 t = *(const f32x4*)(sp + i * 64 + 4 * q4); S2[i][2 * q4] = (f2){t[0], t[1]}; S2[i][2 * q4 + 1] = (f2){t[2], t[3]}; } }
                const LAS float* vp = vec + tt * 384 + 16 * kb;
                f2 w2[8], kk2[8], b2[8], k2[8], r2[8];
#pragma unroll
                for (int q4 = 0; q4 < 4; ++q4) { const f32x4 t0v = *(const LAS f32x4*)(vp + 4 * q4), t1 = *(const LAS f32x4*)(vp + 64 + 4 * q4), t2 = *(const LAS f32x4*)(vp + 128 + 4 * q4),
                        t3 = *(const LAS f32x4*)(vp + 192 + 4 * q4);
                    w2[2 * q4] = (f2){t0v[0], t0v[1]}; w2[2 * q4 + 1] = (f2){t0v[2], t0v[3]}; kk2[2 * q4] = (f2){t1[0], t1[1]}; kk2[2 * q4 + 1] = (f2){t1[2], t1[3]};
                    b2[2 * q4] = (f2){t2[0], t2[1]}; b2[2 * q4 + 1] = (f2){t2[2], t2[3]}; k2[2 * q4] = (f2){t3[0], t3[1]}; k2[2 * q4 + 1] = (f2){t3[2], t3[3]};
                    if (MODE != 1) { const f32x4 t4 = *(const LAS f32x4*)(vp + 256 + 4 * q4); r2[2 * q4] = (f2){t4[0], t4[1]}; r2[2 * q4 + 1] = (f2){t4[2], t4[3]}; } }
                const f32x4 v4 = *(const LAS f32x4*)(vec + tt * 384 + 320 + 4 * vb);
                f32x4 yv;
                {
                    f2 a2[4]; float sa[4], pa[4];
#pragma unroll
                    for (int i = 0; i < 4; ++i) a2[i] = (f2){0.f, 0.f};
#pragma unroll
                    for (int j = 0; j < 8; ++j)
#pragma unroll
                        for (int i = 0; i < 4; ++i) a2[i] += S2[i][j] * kk2[j];
#pragma unroll
                    for (int i = 0; i < 4; ++i) { float a = a2[i].x + a2[i].y; a += dpp_xor1(a); a += dpp_xor2(a); sa[i] = -a; }
                    if (MODE == 1) {
#pragma unroll
                        for (int i = 0; i < 4; ++i) a2[i] = (f2){0.f, 0.f};
#pragma unroll
                        for (int j = 0; j < 8; ++j)
#pragma unroll
                            for (int i = 0; i < 4; ++i) a2[i] += Pm2[i][j] * kk2[j];
#pragma unroll
                        for (int i = 0; i < 4; ++i) { float q = a2[i].x + a2[i].y; q += dpp_xor1(q); q += dpp_xor2(q); pa[i] = -q; } }
#pragma unroll
                    for (int i = 0; i < 4; ++i) { const f2 sa2 = (f2){sa[i], sa[i]}, vi2 = (f2){v4[i], v4[i]};
#pragma unroll
                        for (int j = 0; j < 8; ++j) S2[i][j] = S2[i][j] * w2[j] + sa2 * b2[j] + vi2 * k2[j];
                        if (MODE == 1) { const f2 pa2 = (f2){pa[i], pa[i]};
#pragma unroll
                            for (int j = 0; j < 8; ++j) Pm2[i][j] = Pm2[i][j] * w2[j] + pa2 * b2[j]; } }
                    if (MODE != 1) { f2 y2[4];
#pragma unroll
                        for (int i = 0; i < 4; ++i) y2[i] = (f2){0.f, 0.f};
#pragma unroll
                        for (int j = 0; j < 8; ++j)
#pragma unroll
                            for (int i = 0; i < 4; ++i) y2[i] += S2[i][j] * r2[j];
#pragma unroll
                        for (int i = 0; i < 4; ++i) { float y = y2[i].x + y2[i].y; y += dpp_xor1(y); y += dpp_xor2(y); yv[i] = y; } }
                }
                if (MODE != 1 && kb == 0) *(LAS f32x4*)(ybuf + tt * 64 + 4 * vb) = yv;
                if (SAMPLE) { float* sp = outp_ + O_SS + (((size_t)(m - MPROMPT) * 8 + h) * 64 + 4 * vb) * 64 + 16 * kb;
#pragma unroll
                    for (int i = 0; i < 4; ++i)
#pragma unroll
                        for (int q4 = 0; q4 < 4; ++q4) *(f32x4*)(sp + i * 64 + 4 * q4) = (f32x4){S2[i][2 * q4].x, S2[i][2 * q4].y, S2[i][2 * q4 + 1].x, S2[i][2 * q4 + 1].y}; }
            }
            if (MODE != 1) {
#pragma unroll
                for (int tt = 0; tt < 4; ++tt) {
                    const int tl = 4 * sub + tt, m = m0 + 16 * grp + tl;
                    const float y = ybuf[tt * 64 + lane]; const float mean = wave_sum_fast(y) * (1.f / 64.f); const float dd = y - mean;
                    const float var = wave_sum_fast(dd * dd) * (1.f / 64.f);
                    const float yn = dd * __builtin_amdgcn_rsqf(var + 64e-5f) * lnw + lnb;
                    const float o = (yn + bonl[tt] * vec[tt * 384 + 320 + lane]) * bf2f(gg[tl * 64 + lane]);
                    oa[(size_t)m * 512 + ch] = (bf16)f2bf(o);
                }
            }
        }
    }
    {   const int vb = lane0 >> 2, kb = lane0 & 3;
        if (MODE == 2 && s_out) { float* sp = s_out + (size_t)(4 * vb) * 64 + 16 * kb;
#pragma unroll
            for (int i = 0; i < 4; ++i)
#pragma unroll
                for (int q4 = 0; q4 < 4; ++q4) *(f32x4*)(sp + i * 64 + 4 * q4) = (f32x4){S2[i][2 * q4].x, S2[i][2 * q4].y, S2[i][2 * q4 + 1].x, S2[i][2 * q4 + 1].y}; }
        if (MODE == 1) { float* sp = lbuf + (size_t)(4 * vb) * 64 + 16 * kb;
#pragma unroll
            for (int i = 0; i < 4; ++i)
#pragma unroll
                for (int q4 = 0; q4 < 4; ++q4) *(f32x4*)(sp + i * 64 + 4 * q4) = (f32x4){S2[i][2 * q4].x, S2[i][2 * q4].y, S2[i][2 * q4 + 1].x, S2[i][2 * q4 + 1].y};
            const int p0 = 32 * (vb >> 3) + 8 * (vb & 3) + 4 * ((vb >> 2) & 1);
#pragma unroll
            for (int j = 0; j < 16; ++j) { typedef unsigned u32x2 __attribute__((ext_vector_type(2)));
                unsigned hi[4]; float lo[4];
#pragma unroll
                for (int i = 0; i < 4; ++i) { hi[i] = f2bf(Pm2[i][j >> 1][j & 1]); lo[i] = Pm2[i][j >> 1][j & 1] - __builtin_bit_cast(float, hi[i] << 16); }
                u32x2 wh, wlo; wh.x = hi[0] | (hi[1] << 16); wh.y = hi[2] | (hi[3] << 16); wlo.x = pk2(lo[0], lo[1]); wlo.y = pk2(lo[2], lo[3]);
                *(u32x2*)(pth + (size_t)(16 * kb + j) * 64 + p0) = wh; (void)wlo; (void)ptl; }
        }
    }
}
__device__ __forceinline__ void rwkv_combine(Frame& F, int chain) {
    const int lane = lane_id_asm(), v = lane & 15, gq = lane >> 4, w = F.wave, tid = w * 64 + lane;
    float* lbase = out_ptr() + (size_t)chain * 128 * 4096;
    const bf16* phg = (const bf16*)(out_ptr() + (size_t)2048 * 4096) + (size_t)chain * 128 * 4096;
    constexpr int SLOT = 26624, OFF_L = 9216;
    const int prow = tid >> 3, pch = tid & 7; const size_t pg = (size_t)prow * 64 + 8 * pch; const int pl_ = (prow * 72 + 8 * pch) * 2;
    const int lr0 = tid >> 4, lc = tid & 15; const size_t lg0 = (size_t)lr0 * 64 + 4 * lc, lg1 = lg0 + (size_t)32 * 64; const int ll0 = OFF_L + (lr0 * 68 + 4 * lc) * 4, ll1 = ll0 + 32 * 68 * 4;
    v4u ra[3], rb[3];
#define CMB_LOAD(R, c) do { R[0] = *(const v4u*)(phg + (size_t)(c) * 4096 + pg); R[1] = *(const v4u*)(lbase + (size_t)(c) * 4096 + lg0); R[2] = *(const v4u*)(lbase + (size_t)(c) * 4096 + lg1); } while (0)
#define CMB_WRITE(R, so) do { LAS unsigned char* sb_ = F.lds + (so); *(LAS v4u*)(sb_ + pl_) = R[0]; *(LAS v4u*)(sb_ + ll0) = R[1]; *(LAS v4u*)(sb_ + ll1) = R[2]; } while (0)
#define CMB_BAR() do { asm volatile("s_waitcnt lgkmcnt(0)" ::: "memory"); __builtin_amdgcn_s_barrier(); asm volatile("" ::: "memory"); } while (0)
    f32x4 Sacc[4];
    {   const float* l0 = lbase + (size_t)(16 * (w & 3) + v) * 64 + 4 * gq;
#pragma unroll
        for (int T = 0; T < 4; ++T) Sacc[T] = *(const f32x4*)(l0 + 16 * T); }
    CMB_LOAD(ra, 1); CMB_WRITE(ra, SLOT); CMB_LOAD(ra, 2); CMB_WRITE(ra, 2 * SLOT);
    CMB_LOAD(ra, 3); CMB_LOAD(rb, 4);
    __syncthreads();
    int s_cur = SLOT, s_nxt = 2 * SLOT, s_fre = 0;
#pragma unroll 1
    for (int c = 1; c < 127; ++c) {
        if (w < 4) {
            const LAS unsigned char* sb = F.lds + s_cur;
            f32x4 acc[4]; bf16x8 bh[2], bl[2], ah[4][2];
#pragma unroll
            for (int T = 0; T < 4; ++T) acc[T] = *(const LAS f32x4*)(sb + OFF_L + ((16 * w + v) * 68 + 16 * T + 4 * gq) * 4);
#pragma unroll
            for (int T = 0; T < 4; ++T)
#pragma unroll
                for (int s = 0; s < 2; ++s) ah[T][s] = *(const LAS bf16x8*)(sb + ((16 * T + v) * 72 + 32 * s + 8 * gq) * 2);
#pragma unroll
            for (int s = 0; s < 2; ++s) { v4u hw, lw;
#pragma unroll
                for (int p = 0; p < 4; ++p) { const float x0 = Sacc[2 * s + (p >> 1)][2 * (p & 1)], x1 = Sacc[2 * s + (p >> 1)][2 * (p & 1) + 1];
                    const unsigned hp = pg8::cvt_pk_bf16(x0, x1);
                    const float l0 = x0 - __builtin_bit_cast(float, hp << 16), l1 = x1 - __builtin_bit_cast(float, hp & 0xffff0000u);
                    hw[p] = hp; lw[p] = pg8::cvt_pk_bf16(l0, l1); }
                bh[s] = as_frag(hw); bl[s] = as_frag(lw); }
#pragma unroll
            for (int s = 0; s < 2; ++s) {
#pragma unroll
                for (int T = 0; T < 4; ++T) acc[T] = MFMA16(ah[T][s], bh[s], acc[T]);
#pragma unroll
                for (int T = 0; T < 4; ++T) acc[T] = MFMA16(ah[T][s], bl[s], acc[T]); }
            float* so = lbase + (size_t)c * 4096 + (size_t)(16 * w + v) * 64 + 4 * gq;
#pragma unroll
            for (int T = 0; T < 4; ++T) { Sacc[T] = acc[T]; *(f32x4*)(so + 16 * T) = acc[T]; }
        }
        if (c + 2 < 127) CMB_WRITE(ra, s_fre);
#pragma unroll
        for (int i = 0; i < 3; ++i) ra[i] = rb[i];
        if (c + 4 < 127) CMB_LOAD(rb, c + 4);
        CMB_BAR();
        { const int t_ = s_cur; s_cur = s_nxt; s_nxt = s_fre; s_fre = t_; }
    }
#undef CMB_LOAD
#undef CMB_WRITE
#undef CMB_BAR
}

__global__ void __launch_bounds__(NWAVES * 64, 2) fwd_kernel(Params p) {
    extern __shared__ __attribute__((aligned(16))) unsigned char lds_raw[];
    Frame F;
    F.lds = (LAS unsigned char*)lds_raw; F.wave = __builtin_amdgcn_readfirstlane((int)threadIdx.x >> 6);
    F.G = gridDim.x; F.bid = blockIdx.x;
    volatile LAS unsigned* MISC = (volatile LAS unsigned*)(F.lds + MISC_OFF);
    if ((F.wave * 64 + lane_id_asm()) < 128) MISC[(F.wave * 64 + lane_id_asm())] = 0u;
    __syncthreads();
    XcdBarrier bar = xcd_barrier_post((unsigned*)(ws_ptr() + WS_CTL) + CW_BAR, MISC + 8, F.wave);
    if ((int)ka_tab()[38]) cg::this_grid().sync();
#define ws ws_ptr()
    LAS float* wl = (LAS float*)(F.lds + F.wave * WSZ);

    p0_prologue(F);
    xcd_barrier(bar, F.wave);

#ifndef NO_P1
    for (int rep_ = 0; rep_ < (REPEAT_PHASE == 1 ? 2 : 1); ++rep_)
    {   SEpiBf16 ES{(bf16*)(ws + WS_PROJ) + (size_t)MPROMPT * PC, PC};
        sgemm_block(F, (const bf16*)(ws + WS_XN) + (size_t)MPROMPT * 1024, 1024, (const bf16*)(ws + WS_WIN), 1024, 4, 96, ES);
        SEpiBf16 EM{(bf16*)(ws + WS_KVB), 1024};
        sgemm_block(F, (const bf16*)(ws + WS_XN) + (size_t)MP * 1024, 1024, (const bf16*)(ws + WS_WIN) + (size_t)6144 * 1024, 1024, 16, 32, EM);
        pg8::Gemm g{(const pg8::bf16_t*)(ws + WS_XN), (const pg8::bf16_t*)(ws + WS_WIN), MPROMPT, PC, 1024};
        pg8::StaticOrder S; S.init(MPROMPT, PC, F.G, (int)blockIdx.x);
        EpiP1 E{(pg8::bf16_t*)(ws + WS_PROJ), (pg8::bf16_t*)(ws + WS_KVB)};
        pg8::gemm_phase<EpiP1, pg8::StaticOrder, true, true>(F.lds, g, S, E, F.wave);
    xcd_barrier(bar, F.wave);
    }
#endif
    float* lbuf = out_ptr(); bf16* pth = (bf16*)(out_ptr() + (size_t)2048 * 4096); bf16* ptl = pth + (size_t)2048 * 4096;
    for (int rep_ = 0; rep_ < (REPEAT_PHASE == 2 ? 2 : 1); ++rep_) {
    if (F.bid >= F.G - 2) { for (int i = 0; i < 4; ++i) { const int pr = 4 * (F.bid - (F.G - 2)) + i; mem_prep(F, pr >> 2, pr & 3); } __syncthreads(); }
    for (int t = F.bid * NWAVES + F.wave; t < 2032; t += F.G * NWAVES) {
        const int chain = t / 127, c = t - chain * 127; const size_t slot = (size_t)(chain * 128 + c) * 4096;
        rwkv_task<1>(F, wl, chain & 7, (chain >> 3) * TSEQ + 64 * c, 64 * c, 4, lbuf + slot, pth + slot, ptl + slot, nullptr, 0, 4); }
    xcd_barrier(bar, F.wave);
    }
    for (int rep_ = 0; rep_ < (REPEAT_PHASE == 3 ? 2 : 1); ++rep_) {
    if (F.bid < 16 && rep_ == 0) { rwkv_combine(F, F.bid); __syncthreads(); }
    {
        unsigned* qctr = (unsigned*)(ws + WS_QUEUE) + 128 * rep_;
        for (;;) {
            if (F.wave == 0 && lane_id_asm() == 0) MISC[16] = __hip_atomic_fetch_add(qctr, 1u, __ATOMIC_RELAXED, __HIP_MEMORY_SCOPE_AGENT);
            __syncthreads();
            const int u = (int)MISC[16];
            __syncthreads();
            if (u >= 512) break;
            const int uu = u >> 1, rem = uu & 127;
            if (u & 1) swa_unit(F, uu >> 7, rem & 1, rem >> 1); else mem_unit(F, uu >> 7, rem & 3, rem >> 2);
        }
        for (;;) {
            unsigned tq = 0u; if (lane_id_asm() == 0) tq = __hip_atomic_fetch_add(qctr + 64, 1u, __ATOMIC_RELAXED, __HIP_MEMORY_SCOPE_AGENT);
            const int t = __builtin_amdgcn_readfirstlane((int)tq);
            if (t >= 1282 + NLATE / 4) break;
            if (t < 256) { rwkv_task<0>(F, wl, (t >> 2) & 7, MPROMPT + 16 * (t >> 5), 0, 1, nullptr, nullptr, nullptr, nullptr, t & 3, (t & 3) + 1); }
            else if (t < 768) { const int i = t - 256; mem_sample_task(F, wl, i >> 2, i & 3); }
            else if (t < 1024) { const int i = t - 768; swa_sample_task(F, wl, i >> 1, i & 1); }
            else if (t < 1152) swa_copy_task(t - 1024);
            else if (t >= 1282) { for (int i = 0; i < 4; ++i) tr_late(4 * (t - 1282) + i, wl); }
            else {
                const int rr = t - 1152; const size_t m = rr < 2 ? (size_t)rr * TSEQ + TSEQ - 1 : (size_t)MPROMPT + (rr - 2);
                float* o = rr < 2 ? out_ptr() + O_ZP + (size_t)rr * ZC : out_ptr() + O_ZS + (size_t)(rr - 2) * ZC; const bf16* zr = (const bf16*)(ws + WS_PROJ) + m * PC;
                int l0 = lane_id_asm(); asm volatile("" : "+v"(l0));
#pragma unroll 1
                for (int c = l0; c < ZC; c += 64) o[c] = bf2f(zr[c]); }
        }
    }
    xcd_barrier(bar, F.wave);
    }
#ifndef NO_RW
    for (int rep_ = 0; rep_ < (REPEAT_PHASE == 4 ? 2 : 1); ++rep_)
    for (int t = F.bid * NWAVES + F.wave; t < 2048; t += F.G * NWAVES) { const int chain = t >> 7, c = t & 127;
        rwkv_task<2>(F, wl, chain & 7, (chain >> 3) * TSEQ + 64 * c, 64 * c, 4, c ? lbuf + (size_t)(chain * 128 + c - 1) * 4096 : nullptr, nullptr, nullptr, c == 127 ? out_ptr() + O_SP + (size_t)chain * 4096 : nullptr, 0, 4); }
#endif
    xcd_barrier(bar, F.wave);
#ifndef NO_P5
    for (int rep_ = 0; rep_ < (REPEAT_PHASE == 5 ? 2 : 1); ++rep_)
    {
        pg8::StaticOrder S; S.init(MPROMPT, 1024, F.G, (int)blockIdx.x);
        pg8::bf16_t* gate = (pg8::bf16_t*)(ws + WS_GATE); float* macc = (float*)(ws + WS_MACC); pg8::bf16_t* mrg = (pg8::bf16_t*)(ws + WS_MRG);
        const pg8::bf16_t* xn = (const pg8::bf16_t*)(ws + WS_XN); const pg8::bf16_t* win = (const pg8::bf16_t*)(ws + WS_WIN);
        const size_t so = (size_t)MPROMPT * 1024;
        EpiGate EG{gate}; SEpiGate SG{gate + so};
        { sgemm_block(F, xn + so, 1024, win + (size_t)3072 * 1024, 1024, 4, 32, SG);
          SEpiBr<0> SE{gate + so, macc + so, mrg + so}; sgemm_block(F, (const bf16*)(ws + WS_OA) + (size_t)MPROMPT * 512, 512, (const bf16*)(ws + WS_WBA), 512, 4, 32, SE); }
        { pg8::Gemm g{xn, win + (size_t)3072 * 1024, MPROMPT, 1024, 1024}; pg8::gemm_phase<EpiGate, pg8::StaticOrder, true, true>(F.lds, g, S, EG, F.wave); }
        { pg8::Gemm g{(const pg8::bf16_t*)(ws + WS_OA), (const pg8::bf16_t*)(ws + WS_WBA), MPROMPT, 1024, 512}; EpiBr<0> E{gate, macc, mrg}; pg8::gemm_phase<EpiBr<0>, pg8::StaticOrder, true, true>(F.lds, g, S, E, F.wave); }
        { sgemm_block(F, xn + so, 1024, win + (size_t)4096 * 1024, 1024, 4, 32, SG);
          SEpiBr<1> SE{gate + so, macc + so, mrg + so}; sgemm_block(F, (const bf16*)(ws + WS_OB) + (size_t)MPROMPT * 512, 512, (const bf16*)(ws + WS_WBB), 512, 4, 32, SE); }
        { pg8::Gemm g{xn, win + (size_t)4096 * 1024, MPROMPT, 1024, 1024}; pg8::gemm_phase<EpiGate, pg8::StaticOrder, true, true>(F.lds, g, S, EG, F.wave); }
        { pg8::Gemm g{(const pg8::bf16_t*)(ws + WS_OB), (const pg8::bf16_t*)(ws + WS_WBB), MPROMPT, 1024, 512}; EpiBr<1> E{gate, macc, mrg}; pg8::gemm_phase<EpiBr<1>, pg8::StaticOrder, true, true>(F.lds, g, S, E, F.wave); }
        { sgemm_block(F, xn + so, 1024, win + (size_t)5120 * 1024, 1024, 4, 32, SG);
          SEpiBr<2> SE{gate + so, macc + so, mrg + so}; sgemm_block(F, (const bf16*)(ws + WS_OC) + (size_t)MPROMPT * 512, 512, (const bf16*)(ws + WS_WBC), 512, 4, 32, SE); }
        { pg8::Gemm g{xn, win + (size_t)5120 * 1024, MPROMPT, 1024, 1024}; pg8::gemm_phase<EpiGate, pg8::StaticOrder, true, true>(F.lds, g, S, EG, F.wave); }
        { pg8::Gemm g{(const pg8::bf16_t*)(ws + WS_OC), (const pg8::bf16_t*)(ws + WS_WBC), MPROMPT, 1024, 512}; EpiBr<2> E{gate, macc, mrg}; pg8::gemm_phase<EpiBr<2>, pg8::StaticOrder, true, true>(F.lds, g, S, E, F.wave); }
    }
    xcd_barrier(bar, F.wave);
#endif
#ifndef NO_P6
    {   SEpiOut SE{in_ptr(I_XS), out_ptr() + (size_t)MPROMPT * 1024, (bf16*)(ws + WS_XN) + (size_t)MPROMPT * 1024, (float*)(ws + WS_SQS)};
        sgemm_block(F, (const bf16*)(ws + WS_MRG) + (size_t)MPROMPT * 1024, 1024, (const bf16*)(ws + WS_WOUT), 1024, 4, 32, SE);
        pg8::StaticOrder S; S.init(MPROMPT, 1024, F.G, (int)blockIdx.x);
        pg8::Gemm g{(const pg8::bf16_t*)(ws + WS_MRG), (const pg8::bf16_t*)(ws + WS_WOUT), MPROMPT, 1024, 1024};
        EpiOut E{in_ptr(I_XP), in_ptr(I_XS), out_ptr(), (pg8::bf16_t*)(ws + WS_XN), (float*)(ws + WS_SQ)};
        pg8::gemm_phase<EpiOut, pg8::StaticOrder, true, true>(F.lds, g, S, E, F.wave);
    }
    xcd_barrier(bar, F.wave);
#endif
#ifndef NO_P7
    for (int rep_ = 0; rep_ < (REPEAT_PHASE == 7 ? 2 : 1); ++rep_)
    {   SEpiUp SE{(const float*)(ws + WS_SQS), (bf16*)(ws + WS_H) + (size_t)MPROMPT * 4096};
        sgemm_block(F, (const bf16*)(ws + WS_XN) + (size_t)MPROMPT * 1024, 1024, (const bf16*)(ws + WS_WUP), 1024, 4, 128, SE);
        pg8::StaticOrder S; S.init(MPROMPT, 4096, F.G, (int)blockIdx.x);
        pg8::Gemm g{(const pg8::bf16_t*)(ws + WS_XN), (const pg8::bf16_t*)(ws + WS_WUP), MPROMPT, 4096, 1024};
        EpiUp E{(const float*)(ws + WS_SQ), (pg8::bf16_t*)(ws + WS_H)};
        pg8::gemm_phase<EpiUp, pg8::StaticOrder, true, true>(F.lds, g, S, E, F.wave);
    }
    xcd_barrier(bar, F.wave);
#endif
#ifndef NO_P8
    {   SEpiDown SE{out_ptr() + (size_t)MPROMPT * 1024};
        sgemm_block(F, (const bf16*)(ws + WS_H) + (size_t)MPROMPT * 4096, 4096, (const bf16*)(ws + WS_WDN), 4096, 4, 32, SE);
        pg8::StaticOrder S; S.init(MPROMPT, 1024, F.G, (int)blockIdx.x);
        pg8::Gemm g{(const pg8::bf16_t*)(ws + WS_H), (const pg8::bf16_t*)(ws + WS_WDN), MPROMPT, 1024, 4096};
        EpiDown E{out_ptr()};
        pg8::gemm_phase<EpiDown, pg8::StaticOrder, true, true>(F.lds, g, S, E, F.wave);
    }
#endif
}

#undef ws
extern "C" void kernel_launch(void* const* d_in, const int* in_sizes, int n_in, void* d_out, int out_size, void* d_ws, size_t ws_size, hipStream_t stream) {
    static int grid = 0;
    if (grid == 0) {
        if (n_in != 36 || ws_size < WS_END) { fprintf(stderr, "kernel_launch: unexpected n_in %d / ws %zu\n", n_in, ws_size); grid = -1; return; }
        int dev = 0, cus = 0, per_cu = 0;
        if (hipGetDevice(&dev) != hipSuccess || hipDeviceGetAttribute(&cus, hipDeviceAttributeMultiprocessorCount, dev) != hipSuccess) { grid = -1; return; }
        if (hipFuncSetAttribute((const void*)fwd_kernel, hipFuncAttributeMaxDynamicSharedMemorySize, LDS_BYTES) != hipSuccess) { fprintf(stderr, "kernel_launch: hipFuncSetAttribute failed\n"); grid = -1; return; }
        if (hipOccupancyMaxActiveBlocksPerMultiprocessor(&per_cu, (const void*)fwd_kernel, NWAVES * 64, LDS_BYTES) != hipSuccess || per_cu < 1) { fprintf(stderr, "kernel_launch: occupancy query says %d\n", per_cu); per_cu = 1; }
        (void)hipGetLastError();
        grid = cus;
    }
    if (grid < 0) return;
    if (hipMemsetAsync((char*)d_ws + WS_CTL, 0, CTL_ZERO_BYTES, stream) != hipSuccess) { fprintf(stderr, "kernel_launch: memset failed\n"); return; }
    Params a{};
    for (int i = 0; i < 36; ++i) a.in[i] = (const float*)d_in[i];
    a.out = (float*)d_out; a.ws = (unsigned char*)d_ws; a.never = 0; a.pad = 0;
    void* args[] = {&a};
    hipError_t e = hipLaunchCooperativeKernel((const void*)fwd_kernel, dim3(grid), dim3(NWAVES * 64), args, LDS_BYTES, stream);
    if (e != hipSuccess) fprintf(stderr, "kernel_launch: cooperative launch failed: %s (grid %d)\n", hipGetErrorString(e), grid);
}
```
